# Optimizing an MI355X kernel written in HIP

```python
import math
import jax, jax.numpy as jnp
from jax import lax
import numpy as np

D_MODEL = 2048
BATCH = 2
SEQ = 8192
DEPTH = 1

D_CONV = 1024
CONV_GROUPS = 16
CONV_WIDTH = 3
N_HEADS = 8
QK_NOPE = 128
QK_ROPE = 64
QK_HEAD = QK_NOPE + QK_ROPE
V_HEAD = 128
D_ATTN = N_HEADS * V_HEAD
Q_LORA = 512
KV_LORA = 256
ROPE_BASE = 10000.0
Q_BLOCK = 128
D_MIX = D_CONV + D_ATTN
IN_COLS = 4 * D_CONV + Q_LORA + KV_LORA + QK_ROPE + D_ATTN
EPS = 1e-6

kernel_name = "hymba_conv_mla_adaln_layer"


def _rmsnorm(x, g):
    x32 = x.astype(jnp.float32)
    y = x32 * lax.rsqrt(jnp.mean(x32 * x32, axis=-1, keepdims=True) + EPS)
    return (y * g.astype(jnp.float32)).astype(x.dtype)


def _rope_tables(positions):
    inv_freq = ROPE_BASE ** (-jnp.arange(0, QK_ROPE, 2, dtype=jnp.float32) / QK_ROPE)
    ang = positions.astype(jnp.float32)[..., None] * inv_freq
    return jnp.cos(ang), jnp.sin(ang)


def _apply_rope(x, cos, sin):
    half = QK_ROPE // 2
    x32 = x.astype(jnp.float32)
    x1, x2 = x32[..., :half], x32[..., half:]
    out = jnp.concatenate([x1 * cos - x2 * sin, x1 * sin + x2 * cos], axis=-1)
    return out.astype(x.dtype)


def _short_conv_branch(x_c, b_c, c_c, z_c, conv_w):
    u = c_c * x_c
    seq = u.shape[1]
    u_pad = jnp.pad(u, ((0, 0), (CONV_WIDTH - 1, 0), (0, 0)))
    conv = sum(conv_w[k] * u_pad[:, k:k + seq, :] for k in range(CONV_WIDTH))
    y = b_c * conv
    return y * jax.nn.silu(z_c)


def _causal_blocked_attention(q, k, v):
    bsz, seq = q.shape[0], q.shape[1]
    n_blk = seq // Q_BLOCK
    scale = 1.0 / math.sqrt(QK_HEAD)
    q_blocks = q.reshape(bsz, n_blk, Q_BLOCK, N_HEADS, QK_HEAD).transpose(1, 0, 2, 3, 4)
    key_idx = jnp.arange(seq, dtype=jnp.int32)

    def one_block(args):
        qb, blk = args
        q_idx = blk * Q_BLOCK + jnp.arange(Q_BLOCK, dtype=jnp.int32)
        s = jnp.einsum('bqhd,bkhd->bhqk', qb, k).astype(jnp.float32) * scale
        mask = key_idx[None, :] <= q_idx[:, None]
        s = jnp.where(mask[None, None], s, -jnp.inf)
        p = jax.nn.softmax(s, axis=-1).astype(v.dtype)
        return jnp.einsum('bhqk,bkhd->bqhd', p, v)

    out = lax.map(one_block, (q_blocks, jnp.arange(n_blk, dtype=jnp.int32)))
    return out.transpose(1, 0, 2, 3, 4).reshape(bsz, seq, N_HEADS, V_HEAD)


def _mla_branch(c_q, c_kv, k_rope, z_a, cos, sin, q_a_g, w_q_b, kv_a_g, w_kv_b, q_g, k_g):
    bsz, seq = c_q.shape[0], c_q.shape[1]
    q = (_rmsnorm(c_q, q_a_g) @ w_q_b).reshape(bsz, seq, N_HEADS, QK_HEAD)
    kv = (_rmsnorm(c_kv, kv_a_g) @ w_kv_b).reshape(bsz, seq, N_HEADS, QK_NOPE + V_HEAD)
    k_nope, v = kv[..., :QK_NOPE], kv[..., QK_NOPE:]
    k = jnp.concatenate([k_nope, jnp.broadcast_to(k_rope[:, :, None, :], (bsz, seq, N_HEADS, QK_ROPE))], axis=-1)
    q = _rmsnorm(q, q_g)
    k = _rmsnorm(k, k_g)
    cos_h, sin_h = cos[:, :, None, :], sin[:, :, None, :]
    q = jnp.concatenate([q[..., :QK_NOPE], _apply_rope(q[..., QK_NOPE:], cos_h, sin_h)], axis=-1)
    k = jnp.concatenate([k[..., :QK_NOPE], _apply_rope(k[..., QK_NOPE:], cos_h, sin_h)], axis=-1)
    o = _causal_blocked_attention(q, k, v).reshape(bsz, seq, D_ATTN)
    return o * jax.nn.silu(z_a)


def _layer(x, c, cos, sin, ada_w, ada_b, norm_g, w_in, conv_w, q_a_g, w_q_b, kv_a_g, w_kv_b, q_g, k_g, w_out):
    mod = jax.nn.silu(c) @ ada_w + ada_b
    shift, scale, gate = jnp.split(mod, 3, axis=-1)
    h = _rmsnorm(x, norm_g) * (1.0 + scale[:, None, :]) + shift[:, None, :]
    u = h @ w_in
    splits = np.cumsum([D_CONV, D_CONV, D_CONV, D_CONV, Q_LORA, KV_LORA, QK_ROPE])
    x_c, b_c, c_c, z_c, c_q, c_kv, k_rope, z_a = jnp.split(u, splits.tolist(), axis=-1)
    y_conv = _short_conv_branch(x_c, b_c, c_c, z_c, conv_w)
    y_attn = _mla_branch(c_q, c_kv, k_rope, z_a, cos, sin, q_a_g, w_q_b, kv_a_g, w_kv_b, q_g, k_g)
    y = jnp.concatenate([y_conv, y_attn], axis=-1) @ w_out
    return x + gate[:, None, :] * y


def setup_inputs(seed: int = 0) -> dict:
    key = jax.random.key(seed)
    ks = jax.random.split(key, 20)
    f32 = jnp.float32

    def nrm(k, shape, fan_in, mult=1.0):
        return jax.random.normal(k, shape, f32) * (mult * fan_in ** -0.5)

    def gain(k, shape):
        return 1.0 + 0.02 * jax.random.normal(k, shape, f32)

    x = jax.random.normal(ks[0], (BATCH, SEQ, D_MODEL), f32)
    c = jax.random.normal(ks[1], (BATCH, D_MODEL), f32)
    positions = jnp.broadcast_to(jnp.arange(SEQ, dtype=jnp.int32), (BATCH, SEQ))
    return {
        "x": x,
        "c": c,
        "positions": positions,
        "ada_w": nrm(ks[2], (DEPTH, D_MODEL, 3 * D_MODEL), D_MODEL, 0.5),
        "ada_b": 0.01 * jax.random.normal(ks[3], (DEPTH, 3 * D_MODEL), f32),
        "norm_g": gain(ks[4], (DEPTH, D_MODEL)),
        "w_in": nrm(ks[5], (DEPTH, D_MODEL, IN_COLS), D_MODEL),
        "conv_w": nrm(ks[6], (DEPTH, CONV_WIDTH, D_CONV), CONV_WIDTH),
        "q_a_g": gain(ks[7], (DEPTH, Q_LORA)),
        "w_q_b": nrm(ks[8], (DEPTH, Q_LORA, N_HEADS * QK_HEAD), Q_LORA),
        "kv_a_g": gain(ks[9], (DEPTH, KV_LORA)),
        "w_kv_b": nrm(ks[10], (DEPTH, KV_LORA, N_HEADS * (QK_NOPE + V_HEAD)), KV_LORA),
        "q_g": gain(ks[11], (DEPTH, QK_HEAD)),
        "k_g": gain(ks[12], (DEPTH, QK_HEAD)),
        "w_out": nrm(ks[13], (DEPTH, D_MIX, D_MODEL), D_MIX),
    }


def reference(x, c, positions, ada_w, ada_b, norm_g, w_in, conv_w, q_a_g, w_q_b, kv_a_g, w_kv_b, q_g, k_g, w_out):
    cos, sin = _rope_tables(positions)
    for l in range(DEPTH):
        x = _layer(x, c, cos, sin, ada_w[l], ada_b[l], norm_g[l], w_in[l], conv_w[l],
                   q_a_g[l], w_q_b[l], kv_a_g[l], w_kv_b[l], q_g[l], k_g[l], w_out[l])
    return x
```

```cpp
#include <hip/hip_runtime.h>
#include <hip/hip_cooperative_groups.h>
#include <hip/hip_bf16.h>
#include <cstdio>
#include <cstdint>
namespace cg = cooperative_groups;
namespace pg8 {
#define PG8_LAS __attribute__((address_space(3)))
typedef unsigned short bf16_t;
typedef short bf16x8 __attribute__((ext_vector_type(8)));
typedef float f32x4 __attribute__((ext_vector_type(4)));
typedef unsigned u32x4 __attribute__((ext_vector_type(4)));
constexpr int BM = 256, BK = 64, HALF = 128, HTB = HALF * BK * 2  , STAGE_BYTES = 8 * HTB, NXCD = 8, WGM = 8;

__host__ __device__ __forceinline__ int lds_byte(int r, int c) { const int st = (r >> 4) * 2 + (c >> 5), rr = r & 15, cc = c & 31, ob = rr * 64 + cc * 2; return st * 1024 + (ob ^ (((ob >> 9) & 1) << 5)); }
__host__ __device__ __forceinline__ void stage_rc(int b, int& R, int& C) { const int st = b / 1024, sb = b % 1024, swz = sb ^ (((sb >> 9) & 1) << 5); R = (st >> 1) * 16 + swz / 64; C = (st & 1) * 32 + (swz % 64) / 2; }
__host__ __device__ __forceinline__ int perm32(int rho) { const int n = rho >> 4, i = rho & 15; return 8 * (i >> 2) + 4 * n + (i & 3); }

struct Unit { int pm, pn; };
struct Gemm { const bf16_t* A; const bf16_t* Bt; int M, N, K; };

struct StaticOrder {
    int nM, nN, nwg, G, c;
    __host__ __device__ void init(int M, int N, int G_, int c_) { nM = M / BM; nN = N / BM; nwg = nM * nN; G = G_; c = c_; }
    __host__ __device__ bool next(int i, Unit& u) const {
        const long L = (long)i * G + c; if (L >= nwg) return false;
        int wgid = (int)L; { const int q = nwg / NXCD, r = nwg % NXCD, xcd = wgid % NXCD, off = wgid / NXCD; wgid = (xcd < r ? xcd * (q + 1) : r * (q + 1) + (xcd - r) * q) + off; }
        const int nig = WGM * nN, gid = wgid / nig, fm = gid * WGM, gsz = (nM - fm) < WGM ? (nM - fm) : WGM;
        u.pm = fm + ((wgid % nig) % gsz); u.pn = (wgid % nig) / gsz; return true;
    }
    __device__ __forceinline__ void a_ready(const Unit&) const {}
    __device__ __forceinline__ void done(const Unit&) const {}
};

__device__ __forceinline__ unsigned cvt_pk_bf16(float lo, float hi) { unsigned r; asm volatile("v_cvt_pk_bf16_f32 %0, %1, %2" : "=v"(r) : "v"(lo), "v"(hi)); return r; }
typedef float f32x2 __attribute__((ext_vector_type(2)));
__device__ __forceinline__ f32x2 gelu_pk(f32x2 v) {
    const f32x2 av = __builtin_elementwise_abs(v), d = av * 0.2316418882f + 1.0f;
    f32x2 t; t.x = __builtin_amdgcn_rcpf(d.x); t.y = __builtin_amdgcn_rcpf(d.y);
    f32x2 q = t * 0.5307027145f + (-0.7265760135f); q = q * t + 0.7107068705f; q = q * t + (-0.142248368f); q = q * t + 0.127414796f; q = q * t;
    const f32x2 s = (v * v) * (-0.72134752044f);
    f32x2 e; e.x = __builtin_amdgcn_exp2f(s.x); e.y = __builtin_amdgcn_exp2f(s.y);
    const f32x2 m = v * (q * e), r = v - m;
    f32x2 o; o.x = v.x < 0.f ? m.x : r.x; o.y = v.y < 0.f ? m.y : r.y; return o;
}

template <int ACT  > struct EpiBf16 {
    static constexpr bool PERM = true, AFTER_DRAIN = false; static_assert(ACT == 0 || ACT == 1, "EpiBf16: ACT is 0 (none) or 1 (gelu_pk)");
    bf16_t* O; int ldc; const float* bias; int split_cols; size_t split_stride; float scale0;
    __device__ __forceinline__ void operator()(const f32x4 (&acc)[2][2][4][2], const Unit& u, int wr, int wc, int fr, int fq) const {
        const int row0 = u.pm * BM + wr * 64 + fr; int colt = u.pn * BM; bf16_t* base = O;
        float sc = 1.f; if (split_cols) { const int t = colt / split_cols; base += (size_t)t * split_stride; colt -= t * split_cols; if (t == 0) sc = scale0; }
        const int col0 = colt + wc * 32 + 8 * fq, bcol0 = u.pn * BM + wc * 32 + 8 * fq;
        f32x4 bv[2][2];
#pragma unroll
        for (int bj = 0; bj < 2; ++bj)
#pragma unroll
            for (int n = 0; n < 2; ++n) bv[bj][n] = bias ? *(const f32x4*)(bias + bcol0 + bj * HALF + 4 * n) : (f32x4){0.f, 0.f, 0.f, 0.f};
#pragma unroll
        for (int ai = 0; ai < 2; ++ai)
#pragma unroll
            for (int m = 0; m < 4; ++m) { bf16_t* rowp = base + (size_t)(row0 + ai * HALF + m * 16) * ldc + col0;
#pragma unroll
                for (int bj = 0; bj < 2; ++bj) { f32x4 v0 = acc[ai][bj][m][0] + bv[bj][0], v1 = acc[ai][bj][m][1] + bv[bj][1];
                    if (ACT == 1) { f32x2 a = gelu_pk((f32x2){v0[0], v0[1]}), b = gelu_pk((f32x2){v0[2], v0[3]}), c = gelu_pk((f32x2){v1[0], v1[1]}), d = gelu_pk((f32x2){v1[2], v1[3]});
                        v0 = (f32x4){a.x, a.y, b.x, b.y}; v1 = (f32x4){c.x, c.y, d.x, d.y}; }
                    v0 = v0 * sc; v1 = v1 * sc; u32x4 w; w.x = cvt_pk_bf16(v0[0], v0[1]); w.y = cvt_pk_bf16(v0[2], v0[3]); w.z = cvt_pk_bf16(v1[0], v1[1]); w.w = cvt_pk_bf16(v1[2], v1[3]);
                    *(u32x4*)(rowp + bj * HALF) = w; } }
    }
};
struct EpiOut {
    static constexpr bool PERM = false, AFTER_DRAIN = false;
    const float* x; const float* gate; float* out; int ldc; int rows_per_batch; int gate_stride;
    __device__ __forceinline__ void operator()(const f32x4 (&acc)[2][2][4][2], const Unit& u, int wr, int wc, int fr, int fq) const {
        const int row0 = u.pm * BM + wr * 64 + fr, col0 = u.pn * BM + wc * 32 + 4 * fq;
        const float* gp = gate + (size_t)((u.pm * BM) / rows_per_batch) * gate_stride + col0;
        f32x4 gv[2][2];
#pragma unroll
        for (int bj = 0; bj < 2; ++bj)
#pragma unroll
            for (int n = 0; n < 2; ++n) gv[bj][n] = *(const f32x4*)(gp + bj * HALF + n * 16);
#pragma unroll
        for (int ai = 0; ai < 2; ++ai)
#pragma unroll
            for (int m = 0; m < 4; ++m) { const size_t off = (size_t)(row0 + ai * HALF + m * 16) * ldc + col0;
#pragma unroll
                for (int bj = 0; bj < 2; ++bj)
#pragma unroll
                    for (int n = 0; n < 2; ++n) { const f32x4 xv = __builtin_nontemporal_load((const f32x4*)(x + off + bj * HALF + n * 16));
                        __builtin_nontemporal_store(xv + gv[bj][n] * acc[ai][bj][m][n], (f32x4*)(out + off + bj * HALF + n * 16)); }
                asm volatile("" ::: "memory"); }
    }
};
struct EpiIn {
    static constexpr bool PERM = false, AFTER_DRAIN = false;
    bf16_t* O; int ldc;
    __device__ __forceinline__ void operator()(const f32x4 (&acc)[2][2][4][2], const Unit& u, int wr, int wc, int fr, int fq) const {
        const int row0 = u.pm * BM + wr * 64 + fr;
        if (u.pn < 16) {
            const int col = 8 * (u.pn * 16 + wc * 4 + fq);
#pragma unroll
            for (int ai = 0; ai < 2; ++ai)
#pragma unroll
                for (int m = 0; m < 4; ++m) { bf16_t* rowp = O + (size_t)(row0 + ai * HALF + m * 16) * ldc + col;
                    const f32x4 x = acc[ai][0][m][0], c = acc[ai][0][m][1], b = acc[ai][1][m][0], z = acc[ai][1][m][1];
                    f32x4 u2 = c * x, gz;
#pragma unroll
                    for (int e = 0; e < 4; ++e) gz[e] = b[e] * z[e] * __builtin_amdgcn_rcpf(1.f + __expf(-z[e]));
                    u32x4 w; w.x = cvt_pk_bf16(u2[0], u2[1]); w.y = cvt_pk_bf16(u2[2], u2[3]); w.z = cvt_pk_bf16(gz[0], gz[1]); w.w = cvt_pk_bf16(gz[2], gz[3]);
                    *(u32x4*)(rowp) = w; }
        } else {
            const int col0 = u.pn * BM + wc * 32 + 8 * fq;
            float z0 = 0.f; asm volatile("" : "+v"(z0)); const f32x4 zf = {z0, z0, z0, z0};
#pragma unroll
            for (int ai = 0; ai < 2; ++ai)
#pragma unroll
                for (int m = 0; m < 4; ++m) { bf16_t* rowp = O + (size_t)(row0 + ai * HALF + m * 16) * ldc + col0;
#pragma unroll
                    for (int bj = 0; bj < 2; ++bj) { const f32x4 v0 = acc[ai][bj][m][0] + zf, v1 = acc[ai][bj][m][1] + zf;
                        u32x4 w; w.x = cvt_pk_bf16(v0[0], v0[1]); w.y = cvt_pk_bf16(v0[2], v0[3]); w.z = cvt_pk_bf16(v1[0], v1[1]); w.w = cvt_pk_bf16(v1[2], v1[3]);
                        *(u32x4*)(rowp + bj * HALF) = w; } }
        }
    }
};
struct KvOrder {
    int nM, nN, nwg, G, c; bool bal;
    __host__ __device__ void init(int M, int N, int G_, int c_) { nM = M / BM; nN = N / BM; nwg = nM * nN; G = G_; c = c_; bal = (G_ == 256 && nwg == 512); }
    __host__ __device__ bool next(int i, Unit& u) const {
        long L;
        if (!bal) L = (long)i * G + c;
        else if (c < 128) L = (i == 0) ? c : -1;
        else L = (i == 0) ? c : (i == 1) ? 256 + 2 * (c - 128) : (i == 2) ? 257 + 2 * (c - 128) : -1;
        if (L < 0 || L >= nwg) return false;
        int wgid = (int)L; { const int q = nwg / NXCD, r = nwg % NXCD, xcd = wgid % NXCD, off = wgid / NXCD; wgid = (xcd < r ? xcd * (q + 1) : r * (q + 1) + (xcd - r) * q) + off; }
        const int nig = WGM * nN, gid = wgid / nig, fm = gid * WGM, gsz = (nM - fm) < WGM ? (nM - fm) : WGM;
        u.pm = fm + ((wgid % nig) % gsz); u.pn = (wgid % nig) / gsz; return true;
    }
    __device__ __forceinline__ void a_ready(const Unit&) const {}
    __device__ __forceinline__ void done(const Unit&) const {}
};
template <class Epi, class Sched, bool ALIGN_EPI = false, bool SP2 = false>
__device__ __forceinline__ void gemm_phase(PG8_LAS unsigned char* lds, const Gemm g, const Sched& S, const Epi& E) {
    const int tid = threadIdx.x, wid = __builtin_amdgcn_readfirstlane(tid >> 6), lane = tid & 63, wr = wid >> 2, wc = wid & 3, fr = lane & 15, fq = lane >> 4;
    const int K = g.K, nt = K / BK;
    unsigned voffA[2], voffB[2];
#pragma unroll
    for (int i = 0; i < 2; ++i) { int R, C; stage_rc(tid * 16 + i * 8192, R, C); const int Rb = Epi::PERM ? ((R & ~31) + perm32(R & 31)) : R;
        voffA[i] = (unsigned)(R * K + C) * 2u; voffB[i] = (unsigned)(Rb * K + C) * 2u; }
    const size_t kstep = (size_t)(BK * 2);
    const size_t hstep = (size_t)HALF * K * 2;
    const size_t tstep = 2 * hstep;
    const unsigned ldsw = (unsigned)wid * 1024u;
    const int aoff = lds_byte(wr * 64 + fr, fq * 8), boff = lds_byte(wc * 32 + fr, fq * 8);
#define PG8_SA(b, h) (((b) * 2 + (h)) * HTB)
#define PG8_SB(b, h) ((4 + (b) * 2 + (h)) * HTB)
#define PG8_STAGE(bufoff, gbase, voff) do { _Pragma("unroll") for (int _i = 0; _i < 2; ++_i) \
        __builtin_amdgcn_global_load_lds((const unsigned*)((const char*)(gbase) + (voff)[_i]), (PG8_LAS unsigned*)(lds + (bufoff) + ldsw + _i * 8192), 16, 0, 0); } while (0)
#define PG8_LDA(dst, b, h) do { _Pragma("unroll") for (int m = 0; m < 4; ++m) _Pragma("unroll") for (int k = 0; k < 2; ++k) dst[m][k] = *(const PG8_LAS bf16x8*)(lds + PG8_SA(b, h) + aoff + m * 2048 + k * 1024); } while (0)
#define PG8_LDB(dst, b, h) do { _Pragma("unroll") for (int n = 0; n < 2; ++n) _Pragma("unroll") for (int k = 0; k < 2; ++k) dst[n][k] = *(const PG8_LAS bf16x8*)(lds + PG8_SB(b, h) + boff + n * 2048 + k * 1024); } while (0)
#define PG8_MMA(ai, bj, At, Bt) do { __builtin_amdgcn_s_setprio(1); _Pragma("unroll") for (int m = 0; m < 4; ++m) _Pragma("unroll") for (int n = 0; n < 2; ++n) _Pragma("unroll") for (int k = 0; k < 2; ++k) \
        acc[ai][bj][m][n] = __builtin_amdgcn_mfma_f32_16x16x32_bf16(Bt[n][k], At[m][k], acc[ai][bj][m][n], 0, 0, 0); __builtin_amdgcn_s_setprio(0); } while (0)
#define PG8_WAIT_V(n) asm volatile("s_waitcnt vmcnt(" #n ")" ::: "memory")
#define PG8_WAIT_L(n) asm volatile("s_waitcnt lgkmcnt(" #n ")" ::: "memory")
#define PG8_BAR __builtin_amdgcn_s_barrier()
#define PG8_SCHED __builtin_amdgcn_sched_barrier(0)
    Unit cur, nxt; int ui = 0;
    if (!S.next(0, cur)) return;
    f32x4 acc[2][2][4][2];
#pragma unroll
    for (int a = 0; a < 2; ++a)
#pragma unroll
        for (int b = 0; b < 2; ++b)
#pragma unroll
            for (int m = 0; m < 4; ++m)
#pragma unroll
                for (int n = 0; n < 2; ++n) acc[a][b][m][n] = (f32x4){0.f, 0.f, 0.f, 0.f};
    bf16x8 At[4][2], B0[2][2], B1[2][2];
    const char* cA = (const char*)g.A + (size_t)cur.pm * tstep; const char* cB = (const char*)g.Bt + (size_t)cur.pn * tstep;
    S.a_ready(cur);
    if constexpr (SP2) {
        PG8_STAGE(PG8_SB(0, 0), cB, voffB); PG8_STAGE(PG8_SB(0, 1), cB + hstep, voffB); PG8_STAGE(PG8_SA(0, 0), cA, voffA); PG8_STAGE(PG8_SA(0, 1), cA + hstep, voffA);
        if (wr == 1) PG8_BAR;
        PG8_WAIT_V(2); PG8_BAR;
        PG8_STAGE(PG8_SB(1, 0), cB + kstep, voffB); PG8_STAGE(PG8_SA(1, 0), cA + kstep, voffA); PG8_STAGE(PG8_SB(1, 1), cB + hstep + kstep, voffB);
        PG8_WAIT_V(6); PG8_BAR;
    } else {
        PG8_STAGE(PG8_SB(0, 0), cB, voffB); PG8_STAGE(PG8_SA(0, 0), cA, voffA); PG8_STAGE(PG8_SB(0, 1), cB + hstep, voffB); PG8_STAGE(PG8_SA(0, 1), cA + hstep, voffA);
        if (wr == 1) PG8_BAR;
        PG8_WAIT_V(4); PG8_BAR;
        PG8_STAGE(PG8_SB(1, 0), cB + kstep, voffB); PG8_STAGE(PG8_SA(1, 0), cA + kstep, voffA); PG8_STAGE(PG8_SB(1, 1), cB + hstep + kstep, voffB);
        PG8_WAIT_V(6); PG8_BAR;
    }
    for (;;) {
        const bool has_next = S.next(ui + 1, nxt);
        const char* nA = has_next ? (const char*)g.A + (size_t)nxt.pm * tstep : cA; const char* nB = has_next ? (const char*)g.Bt + (size_t)nxt.pn * tstep : cB;
        for (int t = 0; t < nt; t += 2) {
            const bool last = (t == nt - 2);
            const char* a1 = cA + (size_t)(t + 1) * kstep;
            const char* a2 = last ? nA : cA + (size_t)(t + 2) * kstep; const char* b2 = last ? nB : cB + (size_t)(t + 2) * kstep;
            const char* a3 = a2 + kstep; const char* b3 = b2 + kstep;
            if (last && has_next) S.a_ready(nxt);
            if constexpr (SP2) {
            PG8_LDB(B0, 0, 0); PG8_LDB(B1, 0, 1); PG8_SCHED; PG8_LDA(At, 0, 0); PG8_STAGE(PG8_SA(1, 1), a1 + hstep, voffA);
            PG8_WAIT_V(8); PG8_WAIT_L(0); PG8_BAR; PG8_MMA(0, 0, At, B0); PG8_MMA(0, 1, At, B1); PG8_BAR; PG8_SCHED;
            PG8_LDA(At, 0, 1); PG8_STAGE(PG8_SB(0, 0), b2, voffB); PG8_STAGE(PG8_SB(0, 1), b2 + hstep, voffB); PG8_STAGE(PG8_SA(0, 0), a2, voffA);
            PG8_WAIT_V(8); PG8_WAIT_L(0); PG8_BAR; PG8_MMA(1, 0, At, B0); PG8_MMA(1, 1, At, B1); PG8_BAR; PG8_SCHED;
            PG8_LDB(B0, 1, 0); PG8_LDB(B1, 1, 1); PG8_SCHED; PG8_LDA(At, 1, 0); PG8_STAGE(PG8_SA(0, 1), a2 + hstep, voffA);
            PG8_WAIT_V(8); PG8_WAIT_L(0); PG8_BAR; PG8_MMA(0, 0, At, B0); PG8_MMA(0, 1, At, B1); PG8_BAR; PG8_SCHED;
            PG8_LDA(At, 1, 1); PG8_STAGE(PG8_SB(1, 0), b3, voffB); PG8_STAGE(PG8_SB(1, 1), b3 + hstep, voffB); PG8_STAGE(PG8_SA(1, 0), a3, voffA);
            PG8_WAIT_V(8); PG8_WAIT_L(0); PG8_BAR; PG8_MMA(1, 0, At, B0); PG8_MMA(1, 1, At, B1); PG8_BAR; PG8_SCHED;
            } else {
            PG8_LDB(B0, 0, 0); PG8_SCHED; PG8_LDA(At, 0, 0); PG8_STAGE(PG8_SA(1, 1), a1 + hstep, voffA);
            PG8_WAIT_L(8); PG8_BAR; PG8_WAIT_L(0); PG8_MMA(0, 0, At, B0); PG8_BAR; PG8_SCHED;
            PG8_LDB(B1, 0, 1); PG8_STAGE(PG8_SB(0, 0), b2, voffB);
            PG8_BAR; PG8_WAIT_L(0); PG8_MMA(0, 1, At, B1); PG8_BAR;
            PG8_LDA(At, 0, 1); PG8_STAGE(PG8_SA(0, 0), a2, voffA);
            PG8_BAR; PG8_WAIT_L(0); PG8_MMA(1, 0, At, B0); PG8_BAR; PG8_SCHED;
            PG8_STAGE(PG8_SB(0, 1), b2 + hstep, voffB);
            PG8_WAIT_V(6); PG8_BAR; PG8_MMA(1, 1, At, B1); PG8_BAR;
            PG8_LDB(B0, 1, 0); PG8_SCHED; PG8_LDA(At, 1, 0); PG8_STAGE(PG8_SA(0, 1), a2 + hstep, voffA);
            PG8_WAIT_L(8); PG8_BAR; PG8_WAIT_L(0); PG8_MMA(0, 0, At, B0); PG8_BAR; PG8_SCHED;
            PG8_LDB(B1, 1, 1); PG8_STAGE(PG8_SB(1, 0), b3, voffB);
            PG8_BAR; PG8_WAIT_L(0); PG8_MMA(0, 1, At, B1); PG8_BAR;
            PG8_LDA(At, 1, 1); PG8_STAGE(PG8_SA(1, 0), a3, voffA);
            PG8_BAR; PG8_WAIT_L(0); PG8_MMA(1, 0, At, B0); PG8_BAR; PG8_SCHED;
            PG8_STAGE(PG8_SB(1, 1), b3 + hstep, voffB);
            PG8_WAIT_V(6); PG8_BAR; PG8_MMA(1, 1, At, B1); PG8_BAR;
            }
        }
        if constexpr (ALIGN_EPI) { if (wr == 0) PG8_BAR; }
        if constexpr (!Epi::AFTER_DRAIN) { E(acc, cur, wr, wc, fr, fq); S.done(cur); }
        if (!has_next) break;
#pragma unroll
        for (int a = 0; a < 2; ++a)
#pragma unroll
            for (int b = 0; b < 2; ++b)
#pragma unroll
                for (int m = 0; m < 4; ++m)
#pragma unroll
                    for (int n = 0; n < 2; ++n) acc[a][b][m][n] = (f32x4){0.f, 0.f, 0.f, 0.f};
        cur = nxt; cA = nA; cB = nB; ++ui;
        if constexpr (ALIGN_EPI) { if (wr == 1) PG8_BAR; }
    }
    PG8_WAIT_V(0);
    if constexpr (!ALIGN_EPI) { if (wr == 0) PG8_BAR; }
    PG8_BAR;
    if constexpr (Epi::AFTER_DRAIN) { E.fused(acc, cur, wr, wc, fr, fq, lds, wid, lane); S.done(cur); }
#undef PG8_SA
#undef PG8_SB
#undef PG8_STAGE
#undef PG8_LDA
#undef PG8_LDB
#undef PG8_MMA
#undef PG8_WAIT_V
#undef PG8_WAIT_L
#undef PG8_BAR
#undef PG8_SCHED
}
}
namespace att {
using bf16 = __hip_bfloat16;
typedef short bf16x8 __attribute__((ext_vector_type(8)));
typedef short s16x4 __attribute__((ext_vector_type(4)));
typedef float f32x16 __attribute__((ext_vector_type(16)));
typedef float f32x4 __attribute__((ext_vector_type(4)));
typedef unsigned u32x4 __attribute__((ext_vector_type(4)));
constexpr int SEQ = 8192, NH = 8, DQK = 192, DV = 128;
constexpr int NW = 8, QBLK = 32, KVBLK = 32, QB = NW * QBLK;
constexpr int SUB_V = KVBLK * DV * 2, SUB_K = KVBLK * 528;
constexpr int SHM_V = 2 * SUB_V, SHM_K = 2 * SUB_K, NVS = 3, NKS = 2;
constexpr int LDS_K0 = NVS * SHM_V, LDS_WS = LDS_K0 + NKS * SHM_K, LDS_BYTES = LDS_WS + NW * 64 * 4;
constexpr float SCALE = 0.07216878364870322f;
constexpr float THR2 = 11.5415603f;
constexpr int Q_PITCH = 1536, KV_PITCH = 2048, U_PITCH = 6144, Y_PITCH = 2048, ZA_OFF = 4928, YA_OFF = 1024;

#define KADDR(row, colB) ((row) * 528 + (colB))
#define SBAR() __builtin_amdgcn_sched_barrier(0)
__device__ __forceinline__ int v_st(int k, int c) { const int kk = (k & ~0xC) | ((k & 4) << 1) | ((k & 8) >> 1); return ((kk >> 3) * 4 + (c >> 5)) * 512 + ((kk & 7) * 32 + (c & 31)) * 2; }
__device__ __forceinline__ int v_rd_base(int lane) { return ((lane & 3) << 3) | (((lane >> 2) & 3) << 6) | (((lane >> 4) & 1) << 5) | (((lane >> 5) & 1) << 8); }
constexpr int v_rd_off(int d0, int ks, int half) { return d0 * 512 + ks * 4096 + half * 2048; }
__device__ __forceinline__ int crow(int r, int hi) { return (r & 3) + 8 * (r >> 2) + 4 * hi; }
__device__ __forceinline__ unsigned cvtpk(float lo, float hi) {
    unsigned r; asm volatile("s_nop 0\n\tv_cvt_pk_bf16_f32 %0, %1, %2" : "=v"(r) : "v"(lo), "v"(hi)); return r;
}
__device__ __forceinline__ void cvtpk4(unsigned& a0, unsigned& a1, unsigned& b0, unsigned& b1, float x0, float x1, float x2, float x3, float x4, float x5, float x6, float x7) {
    asm volatile("s_nop 0\n\tv_cvt_pk_bf16_f32 %0, %4, %5\n\tv_cvt_pk_bf16_f32 %1, %6, %7\n\tv_cvt_pk_bf16_f32 %2, %8, %9\n\tv_cvt_pk_bf16_f32 %3, %10, %11"
                 : "=&v"(a0), "=&v"(a1), "=&v"(b0), "=&v"(b1) : "v"(x0), "v"(x1), "v"(x2), "v"(x3), "v"(x4), "v"(x5), "v"(x6), "v"(x7));
}
__device__ __forceinline__ void mask_tile(f32x16& p0, int dq) {
    const float NEG = -__builtin_inff();
#pragma unroll
    for (int r = 0; r < 16; ++r) { const int c = (r & 3) + 8 * (r >> 2); if (dq - c < 0) p0[r] = NEG; }
}
__device__ __forceinline__ void partialSM(f32x16& p0, float& m_reg, float& alpha) {
    float pmax = fmaxf(p0[0], p0[1]);
#pragma unroll
    for (int r = 2; r < 16; ++r) pmax = fmaxf(pmax, p0[r]);
    { auto rr = __builtin_amdgcn_permlane32_swap(__float_as_uint(pmax), __float_as_uint(pmax), false, false);
      pmax = fmaxf(__uint_as_float(rr[0]), __uint_as_float(rr[1])); }
    float mn;
    if (__builtin_expect(__all((pmax - m_reg) <= THR2), 1)) { mn = m_reg; alpha = 1.f; }
    else { mn = fmaxf(m_reg, pmax); alpha = __builtin_amdgcn_exp2f(m_reg - mn); m_reg = mn; }
#pragma unroll
    for (int r = 0; r < 16; ++r) p0[r] = p0[r] - mn;
}
#define PK4(P, B_, OUT) do { unsigned a0, a1, b0, b1; cvtpk4(a0, a1, b0, b1, P[B_+0], P[B_+1], P[B_+2], P[B_+3], P[B_+4], P[B_+5], P[B_+6], P[B_+7]); \
        auto r0 = __builtin_amdgcn_permlane32_swap(a0, b0, false, false); auto r1 = __builtin_amdgcn_permlane32_swap(a1, b1, false, false); \
        u32x4 w = {r0[0], r1[0], r0[1], r1[1]}; OUT = __builtin_bit_cast(bf16x8, w); } while (0)
__device__ __forceinline__ void finishSM(f32x16& p0, float alpha, float& l_reg, bf16x8& pa0, bf16x8& pa1) {
#pragma unroll
    for (int r = 0; r < 16; ++r) p0[r] = __builtin_amdgcn_exp2f(p0[r]);
    float ps = 0;
#pragma unroll
    for (int r = 0; r < 16; ++r) ps += p0[r];
    { auto rr = __builtin_amdgcn_permlane32_swap(__float_as_uint(ps), __float_as_uint(ps), false, false);
      ps = __uint_as_float(rr[0]) + __uint_as_float(rr[1]); }
    l_reg = l_reg * alpha + ps;
    PK4(p0, 0, pa0); PK4(p0, 8, pa1);
}
__device__ __forceinline__ void finishFast(f32x16& p0, float& l_half, bf16x8& pa0, bf16x8& pa1) {
#pragma unroll
    for (int r = 0; r < 16; ++r) p0[r] = __builtin_amdgcn_exp2f(p0[r]);
    float ps0 = p0[0] + p0[1], ps1 = p0[2] + p0[3];
#pragma unroll
    for (int r = 4; r < 16; r += 4) { ps0 += p0[r] + p0[r + 1]; ps1 += p0[r + 2] + p0[r + 3]; }
    l_half += ps0 + ps1;
    PK4(p0, 0, pa0); PK4(p0, 8, pa1);
}
#undef PK4
#define KRD(dst, addr, off) asm volatile("ds_read_b128 %0, %1 offset:%2" : "=&v"(dst) : "v"(addr), "i"(off) : "memory")
#define KWT(n, f) asm volatile("s_waitcnt lgkmcnt(" #n ")" : "+v"(f) :: "memory")
__device__ __forceinline__ void qkt(f32x16& p0, int ka, const bf16x8* qr) {
    bf16x8 f0, f1, f2;
    KRD(f0, ka, 0); KRD(f1, ka, 32);
    p0 = f32x16{};
    KRD(f2, ka, 64);  KWT(2, f0); p0 = __builtin_amdgcn_mfma_f32_32x32x16_bf16(f0, qr[0], p0, 0, 0, 0);
    KRD(f0, ka, 96);  KWT(2, f1); p0 = __builtin_amdgcn_mfma_f32_32x32x16_bf16(f1, qr[1], p0, 0, 0, 0);
    KRD(f1, ka, 128); KWT(2, f2); p0 = __builtin_amdgcn_mfma_f32_32x32x16_bf16(f2, qr[2], p0, 0, 0, 0);
    KRD(f2, ka, 160); KWT(2, f0); p0 = __builtin_amdgcn_mfma_f32_32x32x16_bf16(f0, qr[3], p0, 0, 0, 0);
    KRD(f0, ka, 192); KWT(2, f1); p0 = __builtin_amdgcn_mfma_f32_32x32x16_bf16(f1, qr[4], p0, 0, 0, 0);
    KRD(f1, ka, 224); KWT(2, f2); p0 = __builtin_amdgcn_mfma_f32_32x32x16_bf16(f2, qr[5], p0, 0, 0, 0);
    KRD(f2, ka, 256); KWT(2, f0); p0 = __builtin_amdgcn_mfma_f32_32x32x16_bf16(f0, qr[6], p0, 0, 0, 0);
    KRD(f0, ka, 288); KWT(2, f1); p0 = __builtin_amdgcn_mfma_f32_32x32x16_bf16(f1, qr[7], p0, 0, 0, 0);
    KRD(f1, ka, 320); KWT(2, f2); p0 = __builtin_amdgcn_mfma_f32_32x32x16_bf16(f2, qr[8], p0, 0, 0, 0);
    KRD(f2, ka, 352); KWT(2, f0); p0 = __builtin_amdgcn_mfma_f32_32x32x16_bf16(f0, qr[9], p0, 0, 0, 0);
    KWT(1, f1); p0 = __builtin_amdgcn_mfma_f32_32x32x16_bf16(f1, qr[10], p0, 0, 0, 0);
    KWT(0, f2); p0 = __builtin_amdgcn_mfma_f32_32x32x16_bf16(f2, qr[11], p0, 0, 0, 0);
}
#undef KRD
#undef KWT
__device__ __forceinline__ void pv_tile(f32x16* o, int vb, bf16x8 pa0, bf16x8 pa1) {
#define TRRD(dst, off) asm volatile("ds_read_b64_tr_b16 %0, %1 offset:%2" : "=&v"(dst) : "v"(vb), "i"(off) : "memory")
#define PV_RD(S_, d0) do { TRRD(S_##l0, v_rd_off(d0, 0, 0)); TRRD(S_##h0, v_rd_off(d0, 0, 1)); TRRD(S_##l1, v_rd_off(d0, 1, 0)); TRRD(S_##h1, v_rd_off(d0, 1, 1)); } while (0)
#define PV_WT(n, S_) asm volatile("s_waitcnt lgkmcnt(" #n ")" : "+v"(S_##l0), "+v"(S_##h0), "+v"(S_##l1), "+v"(S_##h1) :: "memory")
#define PV_MM(S_, d0) do { \
        o[d0] = __builtin_amdgcn_mfma_f32_32x32x16_bf16(pa0, (bf16x8){S_##l0[0], S_##l0[1], S_##l0[2], S_##l0[3], S_##h0[0], S_##h0[1], S_##h0[2], S_##h0[3]}, o[d0], 0, 0, 0); \
        o[d0] = __builtin_amdgcn_mfma_f32_32x32x16_bf16(pa1, (bf16x8){S_##l1[0], S_##l1[1], S_##l1[2], S_##l1[3], S_##h1[0], S_##h1[1], S_##h1[2], S_##h1[3]}, o[d0], 0, 0, 0); } while (0)
    s16x4 al0, ah0, al1, ah1, bl0, bh0, bl1, bh1;
    PV_RD(a, 0); PV_RD(b, 1);
    PV_WT(4, a); PV_MM(a, 0);
    PV_RD(a, 2); PV_WT(4, b); PV_MM(b, 1);
    PV_RD(b, 3); PV_WT(4, a); PV_MM(a, 2);
    PV_WT(0, b); PV_MM(b, 3);
#undef PV_MM
#undef PV_WT
#undef PV_RD
#undef TRRD
}
__device__ __forceinline__ float bf2f(unsigned short v) { return __uint_as_float((unsigned)v << 16); }

constexpr int LDS_OST = LDS_K0, OST_WAVE = 8192;
static_assert(NW * OST_WAVE <= NKS * SHM_K, "O stage must fit inside the K ring");
template <bool FAST>
__device__ __forceinline__ void attn_unit(int b, int h, int qb, const bf16* __restrict__ QN, const bf16* __restrict__ KF, const bf16* __restrict__ KV,
                                          const bf16* __restrict__ U, bf16* __restrict__ Y, const float* __restrict__ q_g, const int* __restrict__ posv, const float* __restrict__ invf32, char* lds) {
    const int tid = threadIdx.x, wid = __builtin_amdgcn_readfirstlane(tid >> 6), lane = tid & 63, r32 = lane & 31, hi = lane >> 5;
    const int P0 = qb * QB, NT = (P0 + QB) / KVBLK;
    const size_t row0 = (size_t)b * SEQ;
    char* V_lds = lds; char* K_lds = lds + LDS_K0;
    float* ws = (float*)(lds + LDS_WS) + wid * 64; float* li_l = ws; float* al_l = ws + 32; const float* al_h = al_l + 4 * hi;
    bf16x8 qr[12];
    { const size_t qrow = row0 + P0 + wid * QBLK + r32;
      const bf16* Qw = QN + qrow * Q_PITCH + h * DQK + hi * 8;
#pragma unroll
      for (int d0 = 0; d0 < 12; ++d0) qr[d0] = *reinterpret_cast<const bf16x8*>(Qw + d0 * 16);
      const float pos = (float)posv[qrow];
      int go = hi * 8; asm volatile("" : "+v"(go));
      float ss = 0.f;
#pragma unroll
      for (int d0 = 0; d0 < 12; ++d0) {
#pragma unroll
          for (int e = 0; e < 8; ++e) { const float x = bf2f((unsigned short)qr[d0][e]); ss += x * x; } }
      { auto rr = __builtin_amdgcn_permlane32_swap(__float_as_uint(ss), __float_as_uint(ss), false, false); ss = __uint_as_float(rr[0]) + __uint_as_float(rr[1]); }
      constexpr float QS = 0.07216878364870322f * 1.4426950408889634f;
      const float rs = QS / sqrtf(ss * (1.f / DQK) + 1e-6f);
#pragma unroll
      for (int d0 = 0; d0 < 8; ++d0) { const f32x4 ga = *(const f32x4*)(q_g + d0 * 16 + go), gb = *(const f32x4*)(q_g + d0 * 16 + go + 4);
          const float g8[8] = {ga[0], ga[1], ga[2], ga[3], gb[0], gb[1], gb[2], gb[3]}; u32x4 w;
#pragma unroll
          for (int e = 0; e < 4; ++e) w[e] = cvtpk(bf2f((unsigned short)qr[d0][2 * e]) * rs * g8[2 * e], bf2f((unsigned short)qr[d0][2 * e + 1]) * rs * g8[2 * e + 1]);
          qr[d0] = __builtin_bit_cast(bf16x8, w); }
#pragma unroll
      for (int j = 0; j < 2; ++j) {
          const f32x4 ga = *(const f32x4*)(q_g + (8 + j) * 16 + go), gb = *(const f32x4*)(q_g + (8 + j) * 16 + go + 4);
          const f32x4 gc = *(const f32x4*)(q_g + (10 + j) * 16 + go), gd = *(const f32x4*)(q_g + (10 + j) * 16 + go + 4);
          const f32x4 fa = *(const f32x4*)(invf32 + 16 * j + go), fb = *(const f32x4*)(invf32 + 16 * j + go + 4);
          const float g1[8] = {ga[0], ga[1], ga[2], ga[3], gb[0], gb[1], gb[2], gb[3]}, g2[8] = {gc[0], gc[1], gc[2], gc[3], gd[0], gd[1], gd[2], gd[3]};
          const float fq8[8] = {fa[0], fa[1], fa[2], fa[3], fb[0], fb[1], fb[2], fb[3]};
          float o1[8], o2[8];
#pragma unroll
          for (int e = 0; e < 8; ++e) { const float ang = pos * fq8[e]; double rev = (double)ang * 0.15915494309189535; rev -= __builtin_rint(rev); const float fr = (float)rev;
              const float cs = __builtin_amdgcn_cosf(fr), sn = __builtin_amdgcn_sinf(fr);
              const float y1 = bf2f((unsigned short)qr[8 + j][e]) * rs * g1[e], y2 = bf2f((unsigned short)qr[10 + j][e]) * rs * g2[e];
              o1[e] = y1 * cs - y2 * sn; o2[e] = y1 * sn + y2 * cs; }
          u32x4 w1, w2;
#pragma unroll
          for (int e = 0; e < 4; ++e) { w1[e] = cvtpk(o1[2 * e], o1[2 * e + 1]); w2[e] = cvtpk(o2[2 * e], o2[2 * e + 1]); }
          qr[8 + j] = __builtin_bit_cast(bf16x8, w1); qr[10 + j] = __builtin_bit_cast(bf16x8, w2); } }
    const char* Kbase = (const char*)(KF + ((size_t)(b * NH + h) * SEQ) * DQK);
    const int sr = tid >> 4, sc = (tid & 15) * 8;
    const char* Vbase = (const char*)(KV + row0 * KV_PITCH + h * 256 + 128);
    const unsigned koff = (unsigned)tid * 16u, voff = (unsigned)(sr * KV_PITCH + sc) * 2u;
    const bool k2 = tid < 256;
    int kws0, kws1;
    { int e = tid, row = e / 24, c = e - row * 24; kws0 = KADDR(row, c * 16); e = tid + 512; row = e / 24; c = e - row * 24; kws1 = KADDR(row, c * 16); }
    const int vst0 = v_st(sr, sc);
    const int vb0 = (int)(uintptr_t)V_lds + v_rd_base(lane); const int kl0 = (int)(uintptr_t)K_lds + KADDR(r32, hi * 16);
    bf16x8 st_k0, st_k1, st_v0;
#define KOFF(j) ((((j) >> 1) & 1) * SHM_K + ((j) & 1) * SUB_K)
#define VOFF(j) ((((j) >> 1) % 3) * SHM_V + ((j) & 1) * SUB_V)
#define SLOAD(t) do { const char* kp_ = Kbase + (size_t)(t) * (KVBLK * DQK * 2); const char* vp_ = Vbase + (size_t)(t) * (KVBLK * KV_PITCH * 2); \
        st_k0 = *reinterpret_cast<const bf16x8*>(kp_ + koff); if (k2) st_k1 = *reinterpret_cast<const bf16x8*>(kp_ + koff + 8192u); \
        st_v0 = *reinterpret_cast<const bf16x8*>(vp_ + voff); } while (0)
#define SWRITE(j) do { const int ko_ = KOFF(j), vo_ = VOFF(j); *(bf16x8*)(K_lds + ko_ + kws0) = st_k0; if (k2) *(bf16x8*)(K_lds + ko_ + kws1) = st_k1; \
        *(bf16x8*)(V_lds + vo_ + vst0) = st_v0; } while (0)
#define VMW() asm volatile("s_waitcnt vmcnt(0)" ::: "memory")
    const int qlo = P0 + wid * QBLK, qm = qlo + r32 - 4 * hi;
    float m_reg = -1e30f, l_reg = 0.f; f32x16 o[4] = {};
    f32x16 pA, pB; float al = 1.f; bf16x8 pa0, pa1;
#define RESC(a) do { if (__any((a) < 1.f)) { if (hi == 0) al_l[r32] = (a); asm volatile("s_waitcnt lgkmcnt(0)" ::: "memory");              \
        _Pragma("unroll") for (int d_ = 0; d_ < 4; ++d_) _Pragma("unroll") for (int r = 0; r < 16; ++r) o[d_][r] *= al_h[(r & 3) + 8 * (r >> 2)]; \
        asm volatile("s_waitcnt lgkmcnt(0)" ::: "memory"); } } while (0)
#define MASKT(P_, t) do { const int kb_ = (t) * KVBLK; if (kb_ + KVBLK - 1 > qlo) { int dq_ = qm - kb_; asm volatile("" : "+v"(dq_)); mask_tile(P_, dq_); } } while (0)
#define STEP(PX, PY, t, MASKED) do { \
        SBAR(); qkt(PX, kl0 + KOFF(t), qr); \
        if constexpr (FAST) { finishFast(PY, l_reg, pa0, pa1); asm volatile("" : "+v"(l_reg)); SBAR(); } \
        else { finishSM(PY, al, l_reg, pa0, pa1); SBAR(); RESC(al); SBAR(); } \
        if ((t) + 2 < NT) { VMW(); SWRITE((t) + 2); } \
        if ((t) + 3 < NT) SLOAD((t) + 3); \
        SBAR(); \
        pv_tile(o, vb0 + VOFF((t) - 1), pa0, pa1); \
        if (MASKED) MASKT(PX, t); \
        if constexpr (!FAST) partialSM(PX, m_reg, al); \
        SBAR(); \
        if ((t) & 1) __syncthreads(); } while (0)
    SLOAD(0); VMW(); SWRITE(0); SLOAD(1); VMW(); SWRITE(1); SLOAD(2); __syncthreads();
    qkt(pA, kl0, qr); if (NT == 8) MASKT(pA, 0); if constexpr (!FAST) partialSM(pA, m_reg, al);
    VMW(); SWRITE(2); SLOAD(3);
    int t = 1;
    for (; t + 1 < NT - 8; t += 2) {
        STEP(pB, pA, t, false);
        STEP(pA, pB, t + 1, false);
    }
    for (; t + 1 < NT; t += 2) {
        STEP(pB, pA, t, true);
        STEP(pA, pB, t + 1, true);
    }
    STEP(pB, pA, t, true);
    if constexpr (FAST) { finishFast(pB, l_reg, pa0, pa1); } else { finishSM(pB, al, l_reg, pa0, pa1); RESC(al); }
    SBAR();
    pv_tile(o, vb0 + VOFF(NT - 1), pa0, pa1);
    if constexpr (FAST) { auto rr = __builtin_amdgcn_permlane32_swap(__float_as_uint(l_reg), __float_as_uint(l_reg), false, false); l_reg = __uint_as_float(rr[0]) + __uint_as_float(rr[1]); }
    if (hi == 0) li_l[r32] = l_reg; asm volatile("s_waitcnt lgkmcnt(0)" ::: "memory");
    int h4 = 4 * hi; asm volatile("" : "+v"(h4));
    const float* li_h = li_l + h4;
    unsigned short* stg = (unsigned short*)(lds + LDS_OST + wid * OST_WAVE) + h4 * 128 + r32;
#pragma unroll
    for (int r = 0; r < 16; ++r) { const int cr = (r & 3) + 8 * (r >> 2); const float rl = __builtin_amdgcn_rcpf(li_h[cr]);
#pragma unroll
        for (int d0 = 0; d0 < 4; ++d0) stg[cr * 128 + d0 * 32] = (unsigned short)(cvtpk(o[d0][r] * rl, 0.f) & 0xffffu); }
    asm volatile("s_waitcnt lgkmcnt(0)" ::: "memory");
    { const int ch = lane & 15, rsub = lane >> 4;
      const size_t mrow0 = row0 + P0 + wid * QBLK + rsub;
      const unsigned short* sg = (const unsigned short*)(lds + LDS_OST + wid * OST_WAVE) + rsub * 128 + ch * 8;
      const unsigned short* zp = reinterpret_cast<const unsigned short*>(U) + mrow0 * U_PITCH + ZA_OFF + h * DV + ch * 8;
      unsigned short* yp = reinterpret_cast<unsigned short*>(Y) + mrow0 * Y_PITCH + YA_OFF + h * DV + ch * 8;
#pragma unroll
      for (int i = 0; i < 8; ++i) { const u32x4 ov = *reinterpret_cast<const u32x4*>(sg + i * 4 * 128); const u32x4 zv = *reinterpret_cast<const u32x4*>(zp + (size_t)i * 4 * U_PITCH);
          u32x4 w;
#pragma unroll
          for (int e = 0; e < 4; ++e) { const float z0 = __uint_as_float(zv[e] << 16), z1 = __uint_as_float(zv[e] & 0xffff0000u);
              const float a0 = __uint_as_float(ov[e] << 16), a1 = __uint_as_float(ov[e] & 0xffff0000u);
              w[e] = cvtpk(a0 * z0 * __builtin_amdgcn_rcpf(1.f + __expf(-z0)), a1 * z1 * __builtin_amdgcn_rcpf(1.f + __expf(-z1))); }
          *reinterpret_cast<u32x4*>(yp + (size_t)i * 4 * Y_PITCH) = w; } }
    __syncthreads();
#undef SLOAD
#undef SWRITE
#undef VMW
#undef RESC
#undef MASKT
#undef KOFF
#undef VOFF
#undef STEP
}
#undef SBAR
}
constexpr int BATCH = 2, SEQ = 8192, DM = 2048, M = BATCH * SEQ;
constexpr int D_CONV = 1024, NHEAD = 8, QK_NOPE = 128, QK_ROPE = 64, QK_HEAD = 192, V_HEAD = 128, D_ATTN = 1024, Q_LORA = 512, KV_LORA = 256;
constexpr int IN_COLS = 5952, IN_PAD = 6144, NQ = NHEAD * QK_HEAD  , NKV = NHEAD * (QK_NOPE + V_HEAD)  ;
constexpr int OFF_XC = 0, OFF_BC = 1024, OFF_CC = 2048, OFF_ZC = 3072, OFF_CQ = 4096, OFF_CKV = 4608, OFF_KR = 4864, OFF_ZA = 4928;
constexpr float EPS = 1e-6f;
constexpr size_t MiB = 1u << 20;
constexpr size_t WS_WIN = 1 * MiB, WS_WQ = 26 * MiB, WS_WKV = 28 * MiB, WS_WOUT = 30 * MiB, WS_MOD = 39 * MiB;
constexpr size_t WS_H = 40 * MiB  , WS_U = 104 * MiB  , WS_CQN = 296 * MiB  , WS_CKVN = 312 * MiB  ;
constexpr size_t WS_QRAW = 320 * MiB  , WS_KVRAW = 368 * MiB  , WS_KF = 432 * MiB  , WS_END = 480 * MiB;
constexpr int NWAVES = 8, NTHREADS = 512;
constexpr int LDS_BYTES = 147456;

#define LAS __attribute__((address_space(3)))
typedef unsigned short bf16r;
typedef unsigned v4u __attribute__((ext_vector_type(4)));
typedef float f32x4 __attribute__((ext_vector_type(4)));
__device__ __forceinline__ unsigned f2bf(float f) { unsigned u = __builtin_bit_cast(unsigned, f); return (u + 0x7fffu + ((u >> 16) & 1u)) >> 16; }
__device__ __forceinline__ unsigned pk2(float lo, float hi) { return f2bf(lo) | (f2bf(hi) << 16); }
__device__ __forceinline__ float bfl(unsigned w) { return __uint_as_float(w << 16); }
__device__ __forceinline__ float bfh(unsigned w) { return __uint_as_float(w & 0xffff0000u); }
__device__ __forceinline__ float wave_sum(float v) {
#pragma unroll
    for (int o = 1; o < 64; o <<= 1) v += __shfl_xor(v, o);
    return v;
}
__device__ __forceinline__ float silu_f(float z) { return z / (1.f + __expf(-z)); }

__constant__ __attribute__((aligned(16))) float INVF[32] = {1.0f, 0.7498942613601685f, 0.5623413324356079f, 0.4216965138912201f, 0.3162277638912201f, 0.23713737726211548f, 0.17782793939113617f, 0.133352130651474f,
    0.10000000149011612f, 0.07498941570520401f, 0.05623413249850273f, 0.04216965287923813f, 0.03162277489900589f, 0.023713737726211548f, 0.017782794311642647f, 0.01333521492779255f,
    0.009999999776482582f, 0.007498941849917173f, 0.005623413249850273f, 0.0042169648222625256f, 0.003162277629598975f, 0.00237137358635664f, 0.0017782794311642647f, 0.0013335214462131262f,
    0.0010000000474974513f, 0.0007498942431993783f, 0.000562341301701963f, 0.0004216965171508491f, 0.0003162277571391314f, 0.00023713737027719617f, 0.00017782794020604342f, 0.0001333521504420787f};

struct Args {
    const float* x; const float* c; const int* pos; const float* ada_w; const float* ada_b; const float* norm_g; const float* w_in; const float* conv_w;
    const float* q_a_g; const float* w_q_b; const float* kv_a_g; const float* w_kv_b; const float* q_g; const float* k_g; const float* w_out;
    float* out; unsigned char* ws; int ph_lo, ph_hi;
};

__device__ __forceinline__ int in_row_map(int j) {
    if (j < 4096) { const int ko = j >> 10, ch = j & 1023, k = (ko == 1) ? 2 : (ko == 2) ? 1 : ko;
        return (ch >> 6) * 256 + (k >> 1) * 128 + ((ch >> 4) & 3) * 32 + (k & 1) * 16 + (ch & 15); }
    const int jj = j & 31; return (j & ~31) + 16 * ((jj >> 2) & 1) + 4 * (jj >> 3) + (jj & 3);
}
template <bool MAP>
__device__ __forceinline__ void p0_transpose_item(const float* __restrict__ W, int K, int N, bf16r* __restrict__ WT, LAS float* scr, int item, int lane) {
    const int nblk = N / 32, kb = item / nblk, nb = item % nblk, k0 = 64 * kb, n0 = 32 * nb;
    float wv[32];
#pragma unroll
    for (int i = 0; i < 32; ++i) wv[i] = __builtin_nontemporal_load(W + (size_t)(k0 + 2 * i + (lane >> 5)) * N + n0 + (lane & 31));
#pragma unroll
    for (int i = 0; i < 32; ++i) scr[(2 * i + (lane >> 5)) * 33 + (lane & 31)] = wv[i];
    asm volatile("s_waitcnt lgkmcnt(0)" ::: "memory");
    const int c = lane & 7;
#pragma unroll
    for (int j = 0; j < 4; ++j) { const int n = (lane >> 3) + 8 * j; const LAS float* s = scr + (8 * c) * 33 + n;
        v4u o; o.x = pk2(s[0 * 33], s[1 * 33]); o.y = pk2(s[2 * 33], s[3 * 33]); o.z = pk2(s[4 * 33], s[5 * 33]); o.w = pk2(s[6 * 33], s[7 * 33]);
        const int nr = MAP ? in_row_map(n0 + n) : n0 + n;
        *(v4u*)(WT + (size_t)nr * K + k0 + 8 * c) = o; }
    asm volatile("s_waitcnt lgkmcnt(0)" ::: "memory");
}

__device__ __forceinline__ void phase0(const Args& a, LAS unsigned char* lds) {
    const int tid = threadIdx.x, wid = __builtin_amdgcn_readfirstlane(tid >> 6), lane = tid & 63;
    const int G = gridDim.x, bid = blockIdx.x;
    unsigned char* ws = a.ws;
    LAS float* sc = (LAS float*)lds;
    LAS float* red = (LAS float*)(lds + 16384);
    LAS float* scr = (LAS float*)(lds + 32768 + wid * 8448);
    float* MOD = (float*)(ws + WS_MOD);
    constexpr int N_GEMV = (3 * DM) / 32;
    if (bid < N_GEMV) {
        for (int i = tid; i < 2 * DM; i += NTHREADS) sc[i] = silu_f(a.c[i]);
        __syncthreads();
        for (int it = bid; it < N_GEMV; it += G) {
            const int n0 = it * 32, cl = lane & 7, ks = lane >> 3;
            const float* wp = a.ada_w + (size_t)(wid * 256 + ks) * (3 * DM) + n0 + cl * 4;
            f32x4 acc0 = {0.f, 0.f, 0.f, 0.f}, acc1 = {0.f, 0.f, 0.f, 0.f};
#pragma unroll 16
            for (int j = 0; j < 32; ++j) { const f32x4 w = __builtin_nontemporal_load((const f32x4*)(wp + (size_t)j * 8 * (3 * DM))); const int k = wid * 256 + j * 8 + ks;
                acc0 += w * sc[k]; acc1 += w * sc[DM + k]; }
#pragma unroll
            for (int e = 0; e < 4; ++e) {
#pragma unroll
                for (int o = 8; o < 64; o <<= 1) { acc0[e] += __shfl_xor(acc0[e], o); acc1[e] += __shfl_xor(acc1[e], o); } }
            if (ks == 0) {
#pragma unroll
                for (int e = 0; e < 4; ++e) { red[(wid * 2 + 0) * 32 + cl * 4 + e] = acc0[e]; red[(wid * 2 + 1) * 32 + cl * 4 + e] = acc1[e]; } }
            __syncthreads();
            if (tid < 64) { const int b = tid >> 5, col = tid & 31; float s = a.ada_b[n0 + col];
#pragma unroll
                for (int w = 0; w < 8; ++w) s += red[(w * 2 + b) * 32 + col];
                MOD[b * (3 * DM) + n0 + col] = s; }
            __syncthreads();
        }
    }
    constexpr int I_IN = (DM / 64) * (IN_COLS / 32), I_Q = (Q_LORA / 64) * (NQ / 32), I_KV = (KV_LORA / 64) * (NKV / 32), I_OUT = (DM / 64) * (DM / 32);
    constexpr int NITEMS = I_IN + I_Q + I_KV + I_OUT, NGROUPS = (NITEMS + 7) / 8;
    bf16r* WinT = (bf16r*)(ws + WS_WIN); bf16r* WqT = (bf16r*)(ws + WS_WQ); bf16r* WkvT = (bf16r*)(ws + WS_WKV); bf16r* WoutT = (bf16r*)(ws + WS_WOUT);
    const int nfree = G > N_GEMV ? G - N_GEMV : 0;
    const int head = nfree * 4 < NGROUPS ? nfree * 4 : 0;
    for (int pass = 0; pass < 2; ++pass) {
        int g, gstep, gend;
        if (pass == 0) { if (bid < N_GEMV || head == 0) continue; g = bid - N_GEMV; gstep = nfree; gend = head; }
        else { g = head + bid; gstep = G; gend = NGROUPS; }
        for (; g < gend; g += gstep) {
            int r = g * 8 + wid; if (r >= NITEMS) continue;
            if (r < I_IN) { p0_transpose_item<true>(a.w_in, DM, IN_COLS, WinT, scr, r, lane); continue; } r -= I_IN;
            if (r < I_Q) { p0_transpose_item<false>(a.w_q_b, Q_LORA, NQ, WqT, scr, r, lane); continue; } r -= I_Q;
            if (r < I_KV) { p0_transpose_item<false>(a.w_kv_b, KV_LORA, NKV, WkvT, scr, r, lane); continue; } r -= I_KV;
            p0_transpose_item<false>(a.w_out, DM, DM, WoutT, scr, r, lane);
        }
    }
    { v4u* z = (v4u*)(WinT + (size_t)IN_COLS * DM); const int nz = (IN_PAD - IN_COLS) * DM / 8;
      for (int i = bid * NTHREADS + tid; i < nz; i += G * NTHREADS) z[i] = (v4u){0u, 0u, 0u, 0u}; }
}

__device__ __forceinline__ void phase1(const Args& a) {
    const int tid = threadIdx.x, wid = __builtin_amdgcn_readfirstlane(tid >> 6), lane = tid & 63;
    const int gw = blockIdx.x * NWAVES + wid, NGW = gridDim.x * NWAVES;
    const float* MOD = (const float*)(a.ws + WS_MOD); bf16r* H = (bf16r*)(a.ws + WS_H);
    f32x4 A[8], Bc[8], nx[8]; int curb = -1;
    { const int m0 = gw < M ? gw : 0; const f32x4* xn = (const f32x4*)(a.x + (size_t)m0 * DM) + 2 * lane;
#pragma unroll
      for (int j = 0; j < 8; ++j) nx[j] = xn[128 * (j >> 1) + (j & 1)]; }
    for (int m = gw; m < M; m += NGW) {
        const int b = m / SEQ;
        if (b != curb) { curb = b;
#pragma unroll
            for (int j = 0; j < 8; ++j) { const int col = 8 * lane + 512 * (j >> 1) + 4 * (j & 1); const f32x4 g = *(const f32x4*)(a.norm_g + col);
                const f32x4 s = *(const f32x4*)(MOD + b * (3 * DM) + DM + col); A[j] = g * (s + 1.0f); Bc[j] = *(const f32x4*)(MOD + b * (3 * DM) + col); } }
        f32x4 v[8]; float ss = 0.f;
#pragma unroll
        for (int j = 0; j < 8; ++j) { v[j] = nx[j]; ss += (v[j].x * v[j].x + v[j].y * v[j].y) + (v[j].z * v[j].z + v[j].w * v[j].w); }
        { const int mn = (m + NGW < M) ? m + NGW : m; const f32x4* xn = (const f32x4*)(a.x + (size_t)mn * DM) + 2 * lane;
#pragma unroll
          for (int j = 0; j < 8; ++j) nx[j] = xn[128 * (j >> 1) + (j & 1)]; }
        const float rstd = 1.0f / sqrtf(wave_sum(ss) * (1.f / DM) + EPS);
        v4u* o16 = (v4u*)(H + (size_t)m * DM) + lane;
#pragma unroll
        for (int j = 0; j < 4; ++j) { const f32x4 h0 = (v[2 * j] * rstd) * A[2 * j] + Bc[2 * j], h1 = (v[2 * j + 1] * rstd) * A[2 * j + 1] + Bc[2 * j + 1];
            v4u o; o.x = pk2(h0.x, h0.y); o.y = pk2(h0.z, h0.w); o.z = pk2(h1.x, h1.y); o.w = pk2(h1.z, h1.w);
            o16[64 * j] = o; }
    }
}

__device__ __forceinline__ void unpack8(const v4u w, float* f) { f[0] = bfl(w.x); f[1] = bfh(w.x); f[2] = bfl(w.y); f[3] = bfh(w.y); f[4] = bfl(w.z); f[5] = bfh(w.z); f[6] = bfl(w.w); f[7] = bfh(w.w); }
struct P3Row { v4u u2[2], gz[2], cq, ckv; };
__device__ __forceinline__ P3Row p3_load(const bf16r* U, int m, int lane) {
    const bf16r* ur = U + (size_t)m * IN_PAD; P3Row r;
#pragma unroll
    for (int q = 0; q < 2; ++q) { const int c16 = (lane + 64 * q) * 16;
        const v4u A = *(const v4u*)(ur + c16), B = *(const v4u*)(ur + c16 + 8); r.u2[q] = (v4u){A.x, A.y, B.x, B.y}; r.gz[q] = (v4u){A.z, A.w, B.z, B.w}; }
    r.cq = *(const v4u*)(ur + OFF_CQ + lane * 8); r.ckv = *(const v4u*)(ur + OFF_CKV + (lane & 31) * 8);
    return r;
}
__device__ __forceinline__ void phase3(const Args& a) {
    const int tid = threadIdx.x, wid = __builtin_amdgcn_readfirstlane(tid >> 6), lane = tid & 63;
    const int gw = blockIdx.x * NWAVES + wid, NGW = gridDim.x * NWAVES;
    const bf16r* U = (const bf16r*)(a.ws + WS_U); bf16r* Y = (bf16r*)(a.ws + WS_H);
    bf16r* CQN = (bf16r*)(a.ws + WS_CQN); bf16r* CKVN = (bf16r*)(a.ws + WS_CKVN);
    const int rpw = (M + NGW - 1) / NGW, m0 = gw * rpw, m1 = (m0 + rpw < M) ? m0 + rpw : M;
    if (m0 >= M) return;
    float w0[2][8], w1[2][8], w2[2][8];
#pragma unroll
    for (int q = 0; q < 2; ++q) { const int ch = (lane + 64 * q) * 8;
#pragma unroll
        for (int e = 0; e < 8; ++e) { w0[q][e] = a.conv_w[ch + e]; w1[q][e] = a.conv_w[D_CONV + ch + e]; w2[q][e] = a.conv_w[2 * D_CONV + ch + e]; } }
    const f32x4 gqa = *(const f32x4*)(a.q_a_g + lane * 8), gqb = *(const f32x4*)(a.q_a_g + lane * 8 + 4);
    const f32x4 gka = *(const f32x4*)(a.kv_a_g + (lane & 31) * 8), gkb = *(const f32x4*)(a.kv_a_g + (lane & 31) * 8 + 4);
    const v4u zero4 = {0u, 0u, 0u, 0u};
    v4u pm1[2], pm2[2];
    { const int t0 = m0 % SEQ;
#pragma unroll
      for (int q = 0; q < 2; ++q) { const int ch = (lane + 64 * q) * 8;
          if (t0 >= 1) { const bf16r* p = U + (size_t)(m0 - 1) * IN_PAD + 2 * ch; const v4u A = *(const v4u*)p, B = *(const v4u*)(p + 8); pm1[q] = (v4u){A.x, A.y, B.x, B.y}; } else pm1[q] = zero4;
          if (t0 >= 2) { const bf16r* p = U + (size_t)(m0 - 2) * IN_PAD + 2 * ch; const v4u A = *(const v4u*)p, B = *(const v4u*)(p + 8); pm2[q] = (v4u){A.x, A.y, B.x, B.y}; } else pm2[q] = zero4; } }
    P3Row cur = p3_load(U, m0, lane);
    for (int m = m0; m < m1; ++m) {
        const P3Row nxt = p3_load(U, (m + 1 < m1) ? m + 1 : m, lane);
        if (m % SEQ == 0) { pm1[0] = zero4; pm1[1] = zero4; pm2[0] = zero4; pm2[1] = zero4; }
#pragma unroll
        for (int q = 0; q < 2; ++q) {
            const int ch = (lane + 64 * q) * 8;
            float c0[8], c1[8], c2[8], g[8], y[8];
            unpack8(cur.u2[q], c0); unpack8(pm1[q], c1); unpack8(pm2[q], c2); unpack8(cur.gz[q], g);
#pragma unroll
            for (int e = 0; e < 8; ++e) y[e] = g[e] * (w2[q][e] * c0[e] + w1[q][e] * c1[e] + w0[q][e] * c2[e]);
            v4u o; o.x = pk2(y[0], y[1]); o.y = pk2(y[2], y[3]); o.z = pk2(y[4], y[5]); o.w = pk2(y[6], y[7]);
            *(v4u*)(Y + (size_t)m * DM + ch) = o;
            pm2[q] = pm1[q]; pm1[q] = cur.u2[q];
        }
        { float f[8]; unpack8(cur.cq, f); float ss = 0.f;
#pragma unroll
          for (int e = 0; e < 8; ++e) ss += f[e] * f[e];
          const float rstd = 1.0f / sqrtf(wave_sum(ss) * (1.f / Q_LORA) + EPS);
          v4u o; o.x = pk2(f[0] * rstd * gqa.x, f[1] * rstd * gqa.y); o.y = pk2(f[2] * rstd * gqa.z, f[3] * rstd * gqa.w);
          o.z = pk2(f[4] * rstd * gqb.x, f[5] * rstd * gqb.y); o.w = pk2(f[6] * rstd * gqb.z, f[7] * rstd * gqb.w);
          *(v4u*)(CQN + (size_t)m * Q_LORA + lane * 8) = o; }
        { float f[8]; const int l2 = lane & 31; unpack8(cur.ckv, f); float ss = 0.f;
#pragma unroll
          for (int e = 0; e < 8; ++e) ss += f[e] * f[e];
          if (lane >= 32) ss = 0.f;
          const float rstd = 1.0f / sqrtf(wave_sum(ss) * (1.f / KV_LORA) + EPS);
          v4u o; o.x = pk2(f[0] * rstd * gka.x, f[1] * rstd * gka.y); o.y = pk2(f[2] * rstd * gka.z, f[3] * rstd * gka.w);
          o.z = pk2(f[4] * rstd * gkb.x, f[5] * rstd * gkb.y); o.w = pk2(f[6] * rstd * gkb.z, f[7] * rstd * gkb.w);
          if (lane < 32) *(v4u*)(CKVN + (size_t)m * KV_LORA + l2 * 8) = o; }
        cur = nxt;
    }
}

struct P5Row { v4u k0, k1, kr; int pos; };
__device__ __forceinline__ P5Row p5_load(const Args& a, int m, int hh, int sub) {
    const bf16r* U = (const bf16r*)(a.ws + WS_U); const bf16r* Q = (const bf16r*)(a.ws + WS_QRAW); const bf16r* KVR = (const bf16r*)(a.ws + WS_KVRAW);
    P5Row r;
    const bf16r* kn = KVR + (size_t)m * NKV + hh * 256 + sub * 16;
    r.k0 = *(const v4u*)(kn); r.k1 = *(const v4u*)(kn + 8);
    r.kr = *(const v4u*)(U + (size_t)m * IN_PAD + OFF_KR + sub * 8);
    r.pos = a.pos[m];
    return r;
}
__device__ __forceinline__ float grp8_sum(float v) { v += __shfl_xor(v, 1); v += __shfl_xor(v, 2); v += __shfl_xor(v, 4); return v; }
__device__ __forceinline__ void p5_proc(const Args& a, int m, int hh, int sub, const P5Row& r, const float* qg, const float* kg, const float* invf) {
    bf16r* Q = (bf16r*)(a.ws + WS_QRAW); bf16r* KF = (bf16r*)(a.ws + WS_KF);
    const int b = m / SEQ, s = m % SEQ;
    float cs[8], sg[8];
#pragma unroll
    for (int e = 0; e < 8; ++e) { const float ang = (float)r.pos * invf[e];
        double rev = (double)ang * 0.15915494309189535; rev -= __builtin_rint(rev); const float fr = (float)rev;
        cs[e] = __builtin_amdgcn_cosf(fr); const float sn = __builtin_amdgcn_sinf(fr); sg[e] = sub < 4 ? -sn : sn; }
    { float n0[8], n1[8], kr[8]; unpack8(r.k0, n0); unpack8(r.k1, n1); unpack8(r.kr, kr);
      float ss = 0.f;
#pragma unroll
      for (int e = 0; e < 8; ++e) ss += n0[e] * n0[e] + n1[e] * n1[e] + kr[e] * kr[e];
      const float rstd = 1.0f / sqrtf(grp8_sum(ss) * (1.f / QK_HEAD) + EPS);
      float y[8];
#pragma unroll
      for (int e = 0; e < 8; ++e) { n0[e] = n0[e] * rstd * kg[e]; n1[e] = n1[e] * rstd * kg[8 + e]; y[e] = kr[e] * rstd * kg[16 + e]; }
#pragma unroll
      for (int e = 0; e < 8; ++e) { const float pr = __shfl_xor(y[e], 4); kr[e] = y[e] * cs[e] + pr * sg[e]; }
      bf16r* ko = KF + ((size_t)(b * NHEAD + hh) * SEQ + s) * QK_HEAD;
      v4u o; o.x = pk2(n0[0], n0[1]); o.y = pk2(n0[2], n0[3]); o.z = pk2(n0[4], n0[5]); o.w = pk2(n0[6], n0[7]); *(v4u*)(ko + sub * 16) = o;
      o.x = pk2(n1[0], n1[1]); o.y = pk2(n1[2], n1[3]); o.z = pk2(n1[4], n1[5]); o.w = pk2(n1[6], n1[7]); *(v4u*)(ko + sub * 16 + 8) = o;
      o.x = pk2(kr[0], kr[1]); o.y = pk2(kr[2], kr[3]); o.z = pk2(kr[4], kr[5]); o.w = pk2(kr[6], kr[7]); *(v4u*)(ko + 128 + sub * 8) = o; }
}
__device__ __forceinline__ void phase5(const Args& a) {
    const int tid = threadIdx.x, wid = __builtin_amdgcn_readfirstlane(tid >> 6), lane = tid & 63, hh = lane >> 3, sub = lane & 7;
    const int gw = blockIdx.x * NWAVES + wid, NGW = gridDim.x * NWAVES;
    float qg[24], kg[24], invf[8];
    constexpr float QS = 0.07216878364870322f * 1.4426950408889634f;
#pragma unroll
    for (int e = 0; e < 8; ++e) { qg[e] = a.q_g[sub * 8 + e] * QS; qg[8 + e] = a.q_g[64 + sub * 8 + e] * QS; qg[16 + e] = a.q_g[128 + sub * 8 + e] * QS;
        kg[e] = a.k_g[sub * 16 + e]; kg[8 + e] = a.k_g[sub * 16 + 8 + e]; kg[16 + e] = a.k_g[128 + sub * 8 + e]; invf[e] = INVF[(sub & 3) * 8 + e]; }
    for (int m = gw; m < M; m += 2 * NGW) {
        const int m2 = m + NGW; const bool has2 = m2 < M;
        const P5Row r0 = p5_load(a, m, hh, sub); const P5Row r1 = p5_load(a, has2 ? m2 : m, hh, sub);
        p5_proc(a, m, hh, sub, r0, qg, kg, invf);
        if (has2) p5_proc(a, m2, hh, sub, r1, qg, kg, invf);
    }
}

#define XB_TMO      128
#define XB_XCNT(j)  (256  + 64 * (j))
#define XB_XSUB(j)  (1280 + 64 * (j))
#define XB_XGEN(j)  (2304 + 64 * (j))
#define XB_TOP      3328
#define XB_TOPGEN   3392
#define XCD_BAR_WORDS 3456
#define XB_SPIN_CAP (1u << 18)

__device__ __forceinline__ unsigned xb_ld(unsigned* p)              { return __hip_atomic_load(p, __ATOMIC_RELAXED, __HIP_MEMORY_SCOPE_AGENT); }
__device__ __forceinline__ unsigned xb_add(unsigned* p, unsigned v) { return __hip_atomic_fetch_add(p, v, __ATOMIC_RELAXED, __HIP_MEMORY_SCOPE_AGENT); }
__device__ __forceinline__ unsigned xb_xcc_id() { return (unsigned)__builtin_amdgcn_s_getreg((3 << 11) | 20) & 0xFu; }
#define XB_SPIN(cond, bar) do { unsigned _sp = 0; while (cond) { __builtin_amdgcn_s_sleep(1); \
    if ((++_sp & 255u) == 0u) { if (xb_ld(&(bar)[XB_TMO])) break; if (_sp > XB_SPIN_CAP) { atomicAdd(&(bar)[XB_TMO], 1u); break; } } } } while (0)

struct XcdBarrier {
    unsigned* bar; unsigned x;
    volatile LAS unsigned* st;
};

__device__ __forceinline__ XcdBarrier xcd_barrier_post(unsigned* bar, volatile LAS unsigned* st) {
    XcdBarrier b; b.bar = bar; b.x = xb_xcc_id(); b.st = st;
    if (threadIdx.x == 0) st[3] = xb_add(&bar[XB_XCNT(b.x)], 1u);
    return b;
}
__device__ __forceinline__ void xcd_barrier_complete(unsigned* bar, unsigned x, unsigned& nloc, unsigned& nx, unsigned& uni) {
    const unsigned G = gridDim.x * gridDim.y * gridDim.z;
    unsigned sum, cnt, mine, sp = 0u, ok32;
    for (;;) {
        sum = 0u; cnt = 0u; mine = 0u; ok32 = 1u;
#pragma unroll
        for (unsigned j = 0; j < 16; ++j) { const unsigned c = xb_ld(&bar[XB_XCNT(j)]); sum += c; cnt += (c > 0u) ? 1u : 0u; mine = (j == x) ? c : mine; ok32 &= ((j < 8u) ? (c == 32u) : (c == 0u)) ? 1u : 0u; }
        if (sum == G) break;
        __builtin_amdgcn_s_sleep(1);
        if ((++sp & 255u) == 0u) { if (xb_ld(&bar[XB_TMO])) break; if (sp > XB_SPIN_CAP) { atomicAdd(&bar[XB_TMO], 1u); break; } }
    }
    nloc = mine > 0u ? mine : 1u; nx = cnt > 0u ? cnt : 1u;
    uni = (sum == G && G == 256u && cnt == 8u && ok32) ? 1u : 0u;
}

__device__ __forceinline__ void xcd_barrier(const XcdBarrier& b) {
    asm volatile("s_waitcnt vmcnt(0)" ::: "memory");
    __syncthreads();
    if (threadIdx.x == 0) {
        unsigned* bar = b.bar;
        __builtin_amdgcn_s_waitcnt(0);
        unsigned nloc = b.st[0], nx = b.st[1];
        if (nloc == 0u) { unsigned uni; xcd_barrier_complete(bar, b.x, nloc, nx, uni); b.st[0] = nloc; b.st[1] = nx; b.st[2] = uni; }
        const unsigned old = xb_add(&bar[XB_XSUB(b.x)], 1u);
        const unsigned gen = old / nloc;
        if (old + 1u == (gen + 1u) * nloc) {
            __builtin_amdgcn_fence(__ATOMIC_RELEASE, "agent");
            asm volatile("s_waitcnt vmcnt(0)" ::: "memory");
            const unsigned og = xb_add(&bar[XB_TOP], 1u);
            const unsigned tg = og / nx;
            if (og + 1u == (tg + 1u) * nx) xb_add(&bar[XB_TOPGEN], 1u);
            else XB_SPIN(xb_ld(&bar[XB_TOPGEN]) == tg, bar);
            __builtin_amdgcn_fence(__ATOMIC_ACQUIRE, "agent");
            xb_add(&bar[XB_XGEN(b.x)], 1u);
            asm volatile("s_waitcnt vmcnt(0)" ::: "memory");
        } else {
            XB_SPIN(xb_ld(&bar[XB_XGEN(b.x)]) == gen, bar);
            __builtin_amdgcn_fence(__ATOMIC_ACQUIRE, "agent");
            asm volatile("s_waitcnt vmcnt(0)" ::: "memory");
        }
    }
    __syncthreads();
}
__global__ void __launch_bounds__(NTHREADS, 2) hymba_fwd(Args a) {
    extern __shared__ __attribute__((aligned(16))) unsigned char lds[];
    cg::grid_group grid = cg::this_grid();
    if (a.ph_hi > 1000) grid.sync();
    LAS unsigned char* l3 = (LAS unsigned char*)lds;
    unsigned char* ws = a.ws;
    const int G = gridDim.x, bid = blockIdx.x;
    const int lo = a.ph_lo, hi = a.ph_hi;
#define IN(k) (lo <= (k) && (k) < hi)
    volatile LAS unsigned* st = (volatile LAS unsigned*)(l3 + LDS_BYTES - 256);
    if (threadIdx.x < 4) st[threadIdx.x] = 0u;
    __syncthreads();
    XcdBarrier bar; bar.bar = (unsigned*)ws; bar.x = 0; bar.st = nullptr;
    if (hi - lo > 1) bar = xcd_barrier_post((unsigned*)ws, st);
#define SEAM(k) do { if (IN(k) && IN((k) + 1)) xcd_barrier(bar); } while (0)
    bf16r* WinT = (bf16r*)(ws + WS_WIN); bf16r* WqT = (bf16r*)(ws + WS_WQ); bf16r* WkvT = (bf16r*)(ws + WS_WKV); bf16r* WoutT = (bf16r*)(ws + WS_WOUT);
    bf16r* H = (bf16r*)(ws + WS_H); bf16r* U = (bf16r*)(ws + WS_U); bf16r* CQN = (bf16r*)(ws + WS_CQN); bf16r* CKVN = (bf16r*)(ws + WS_CKVN);
    bf16r* QRAW = (bf16r*)(ws + WS_QRAW); bf16r* KVRAW = (bf16r*)(ws + WS_KVRAW); bf16r* KF = (bf16r*)(ws + WS_KF);
    const float* MOD = (const float*)(ws + WS_MOD);

    if (IN(0)) phase0(a, l3);
    SEAM(0);
    int cid = bid;
    if (hi - lo > 1 && IN(0) && IN(1)) { const unsigned u_ = st[2], r_ = st[3]; if (__builtin_amdgcn_readfirstlane((int)u_)) cid = __builtin_amdgcn_readfirstlane((int)(r_ * 8u + bar.x)); }
    if (IN(1)) phase1(a);
    SEAM(1);
    if (IN(2)) {
        pg8::Gemm g{H, WinT, M, IN_PAD, DM}; pg8::StaticOrder S; S.init(M, IN_PAD, G, cid);
        pg8::EpiIn E{U, IN_PAD};
        pg8::gemm_phase<pg8::EpiIn, pg8::StaticOrder, true, true>(l3, g, S, E);
    }
    SEAM(2);
    if (IN(3)) phase3(a);
    SEAM(3);
    if (IN(4)) {
        { pg8::Gemm g{CQN, WqT, M, NQ, Q_LORA}; pg8::StaticOrder S; S.init(M, NQ, G, cid);
          pg8::EpiBf16<0> E{QRAW, NQ, nullptr, 0, 0, 1.f};
          pg8::gemm_phase<pg8::EpiBf16<0>, pg8::StaticOrder, true, true>(l3, g, S, E); }
        __syncthreads();
        { pg8::Gemm g{CKVN, WkvT, M, NKV, KV_LORA}; pg8::KvOrder S; S.init(M, NKV, G, cid);
          pg8::EpiBf16<0> E{KVRAW, NKV, nullptr, 0, 0, 1.f};
          pg8::gemm_phase<pg8::EpiBf16<0>, pg8::KvOrder, true, true>(l3, g, S, E); }
    }
    SEAM(4);
    if (IN(5)) phase5(a);
    SEAM(5);
    if (IN(6)) {
        __syncthreads();
        const int vcu = (G % 8 == 0) ? (cid % 8) * (G / 8) + cid / 8 : cid;
        float bq, bk;
        { const int l = threadIdx.x & 63; bq = fmaxf(fmaxf(fabsf(a.q_g[l]), fabsf(a.q_g[64 + l])), fabsf(a.q_g[128 + l])); bk = fmaxf(fmaxf(fabsf(a.k_g[l]), fabsf(a.k_g[64 + l])), fabsf(a.k_g[128 + l]));
#pragma unroll
          for (int o = 1; o < 64; o <<= 1) { bq = fmaxf(bq, __shfl_xor(bq, o)); bk = fmaxf(bk, __shfl_xor(bk, o)); } }
        const bool fast = __builtin_amdgcn_readfirstlane((int)(19.99f * bq * bk <= 100.f)) != 0;
        if ((threadIdx.x >> 6) < 4) __builtin_amdgcn_s_setprio(1);
        for (int item = vcu; item < BATCH * NHEAD * 16; item += G) {
            const int bh = item >> 4, x = item & 15;
            if (fast) {
                att::attn_unit<true>(bh / NHEAD, bh % NHEAD, x, (const att::bf16*)QRAW, (const att::bf16*)KF, (const att::bf16*)KVRAW, (const att::bf16*)U, (att::bf16*)H, a.q_g, a.pos, INVF, (char*)lds);
                att::attn_unit<true>(bh / NHEAD, bh % NHEAD, 31 - x, (const att::bf16*)QRAW, (const att::bf16*)KF, (const att::bf16*)KVRAW, (const att::bf16*)U, (att::bf16*)H, a.q_g, a.pos, INVF, (char*)lds);
            } else {
                att::attn_unit<false>(bh / NHEAD, bh % NHEAD, x, (const att::bf16*)QRAW, (const att::bf16*)KF, (const att::bf16*)KVRAW, (const att::bf16*)U, (att::bf16*)H, a.q_g, a.pos, INVF, (char*)lds);
                att::attn_unit<false>(bh / NHEAD, bh % NHEAD, 31 - x, (const att::bf16*)QRAW, (const att::bf16*)KF, (const att::bf16*)KVRAW, (const att::bf16*)U, (att::bf16*)H, a.q_g, a.pos, INVF, (char*)lds);
            }
        }
    }
    if (IN(6)) __builtin_amdgcn_s_setprio(0);
    SEAM(6);
    if (IN(7)) {
        __syncthreads();
        pg8::Gemm g{H, WoutT, M, DM, DM}; pg8::StaticOrder S; S.init(M, DM, G, cid);
        pg8::EpiOut E{a.x, MOD + 2 * DM, a.out, DM, SEQ, 3 * DM};
        pg8::gemm_phase<pg8::EpiOut, pg8::StaticOrder, true, true>(l3, g, S, E);
    }
#undef IN
#undef SEAM
}

#ifndef N_LAUNCH_MODE
#define N_LAUNCH_MODE 1
#endif
extern "C" void kernel_launch(void* const* d_in, const int* in_sizes, int n_in, void* d_out, int out_size, void* d_ws, size_t ws_size, hipStream_t stream) {
    static int grid = 0;
    if (grid == 0) {
        if (n_in != 15 || in_sizes[0] != M * DM || out_size != M * DM || ws_size < WS_END) { fprintf(stderr, "kernel_launch: unexpected shapes (n_in %d, in0 %d, out %d, ws %zu)\n", n_in, n_in > 0 ? in_sizes[0] : -1, out_size, ws_size); grid = -1; return; }
        int dev = 0, cus = 0, per_cu = 0;
        (void)hipGetDevice(&dev); (void)hipDeviceGetAttribute(&cus, hipDeviceAttributeMultiprocessorCount, dev);
        if (hipFuncSetAttribute((const void*)hymba_fwd, hipFuncAttributeMaxDynamicSharedMemorySize, LDS_BYTES) != hipSuccess) { fprintf(stderr, "kernel_launch: hipFuncSetAttribute failed\n"); grid = -1; return; }
        if (hipOccupancyMaxActiveBlocksPerMultiprocessor(&per_cu, (const void*)hymba_fwd, NTHREADS, LDS_BYTES) != hipSuccess || per_cu < 1) per_cu = 1;
        (void)hipGetLastError();
        if (cus <= 0) cus = 256;
        grid = cus;
    }
    if (grid < 0) return;
    if (hipMemsetAsync(d_ws, 0, 65536, stream) != hipSuccess) { fprintf(stderr, "kernel_launch: memset failed\n"); return; }
    Args a{};
    a.x = (const float*)d_in[0]; a.c = (const float*)d_in[1]; a.pos = (const int*)d_in[2]; a.ada_w = (const float*)d_in[3]; a.ada_b = (const float*)d_in[4];
    a.norm_g = (const float*)d_in[5]; a.w_in = (const float*)d_in[6]; a.conv_w = (const float*)d_in[7]; a.q_a_g = (const float*)d_in[8]; a.w_q_b = (const float*)d_in[9];
    a.kv_a_g = (const float*)d_in[10]; a.w_kv_b = (const float*)d_in[11]; a.q_g = (const float*)d_in[12]; a.k_g = (const float*)d_in[13]; a.w_out = (const float*)d_in[14];
    a.out = (float*)d_out; a.ws = (unsigned char*)d_ws;
#if N_LAUNCH_MODE == 1
    a.ph_lo = 0; a.ph_hi = 8;
    void* args[] = {&a};
    hipError_t e = hipLaunchCooperativeKernel((const void*)hymba_fwd, dim3(grid), dim3(NTHREADS), args, LDS_BYTES, stream);
    if (e != hipSuccess) fprintf(stderr, "kernel_launch: cooperative launch failed: %s (grid %d)\n", hipGetErrorString(e), grid);
#else
    for (int p = 0; p < 8; ++p) { a.ph_lo = p; a.ph_hi = p + 1; hipLaunchKernelGGL(hymba_fwd, dim3(grid), dim3(NTHREADS), LDS_BYTES, stream, a); }
#endif
}
```

```cpp
#include <hip/hip_runtime.h>
#include <hip/hip_cooperative_groups.h>
#include <hip/hip_bf16.h>
#include <cstdio>
#include <cstdint>
namespace cg = cooperative_groups;
namespace pg8 {
#define PG8_LAS __attribute__((address_space(3)))
typedef unsigned short bf16_t;
typedef short bf16x8 __attribute__((ext_vector_type(8)));
typedef float f32x4 __attribute__((ext_vector_type(4)));
typedef unsigned u32x4 __attribute__((ext_vector_type(4)));
constexpr int BM = 256, BK = 64, HALF = 128, HTB = HALF * BK * 2  , STAGE_BYTES = 8 * HTB, NXCD = 8, WGM = 8;

__host__ __device__ __forceinline__ int lds_byte(int r, int c) { const int st = (r >> 4) * 2 + (c >> 5), rr = r & 15, cc = c & 31, ob = rr * 64 + cc * 2; return st * 1024 + (ob ^ (((ob >> 9) & 1) << 5)); }
__host__ __device__ __forceinline__ void stage_rc(int b, int& R, int& C) { const int st = b / 1024, sb = b % 1024, swz = sb ^ (((sb >> 9) & 1) << 5); R = (st >> 1) * 16 + swz / 64; C = (st & 1) * 32 + (swz % 64) / 2; }
__host__ __device__ __forceinline__ int perm32(int rho) { const int n = rho >> 4, i = rho & 15; return 8 * (i >> 2) + 4 * n + (i & 3); }

struct Unit { int pm, pn; };
struct Gemm { const bf16_t* A; const bf16_t* Bt; int M, N, K; };

struct StaticOrder {
    int nM, nN, nwg, G, c;
    __host__ __device__ void init(int M, int N, int G_, int c_) { nM = M / BM; nN = N / BM; nwg = nM * nN; G = G_; c = c_; }
    __host__ __device__ bool next(int i, Unit& u) const {
        const long L = (long)i * G + c; if (L >= nwg) return false;
        int wgid = (int)L; { const int q = nwg / NXCD, r = nwg % NXCD, xcd = wgid % NXCD, off = wgid / NXCD; wgid = (xcd < r ? xcd * (q + 1) : r * (q + 1) + (xcd - r) * q) + off; }
        const int nig = WGM * nN, gid = wgid / nig, fm = gid * WGM, gsz = (nM - fm) < WGM ? (nM - fm) : WGM;
        u.pm = fm + ((wgid % nig) % gsz); u.pn = (wgid % nig) / gsz; return true;
    }
    __device__ __forceinline__ void a_ready(const Unit&) const {}
    __device__ __forceinline__ void done(const Unit&) const {}
};

__device__ __forceinline__ unsigned cvt_pk_bf16(float lo, float hi) { unsigned r; asm volatile("v_cvt_pk_bf16_f32 %0, %1, %2" : "=v"(r) : "v"(lo), "v"(hi)); return r; }
typedef float f32x2 __attribute__((ext_vector_type(2)));
__device__ __forceinline__ f32x2 gelu_pk(f32x2 v) {
    const f32x2 av = __builtin_elementwise_abs(v), d = av * 0.2316418882f + 1.0f;
    f32x2 t; t.x = __builtin_amdgcn_rcpf(d.x); t.y = __builtin_amdgcn_rcpf(d.y);
    f32x2 q = t * 0.5307027145f + (-0.7265760135f); q = q * t + 0.7107068705f; q = q * t + (-0.142248368f); q = q * t + 0.127414796f; q = q * t;
    const f32x2 s = (v * v) * (-0.72134752044f);
    f32x2 e; e.x = __builtin_amdgcn_exp2f(s.x); e.y = __builtin_amdgcn_exp2f(s.y);
    const f32x2 m = v * (q * e), r = v - m;
    f32x2 o; o.x = v.x < 0.f ? m.x : r.x; o.y = v.y < 0.f ? m.y : r.y; return o;
}

template <int ACT  > struct EpiBf16 {
    static constexpr bool PERM = true, AFTER_DRAIN = false; static_assert(ACT == 0 || ACT == 1, "EpiBf16: ACT is 0 (none) or 1 (gelu_pk)");
    bf16_t* O; int ldc; const float* bias; int split_cols; size_t split_stride; float scale0;
    __device__ __forceinline__ void operator()(const f32x4 (&acc)[2][2][4][2], const Unit& u, int wr, int wc, int fr, int fq) const {
        const int row0 = u.pm * BM + wr * 64 + fr; int colt = u.pn * BM; bf16_t* base = O;
        float sc = 1.f; if (split_cols) { const int t = colt / split_cols; base += (size_t)t * split_stride; colt -= t * split_cols; if (t == 0) sc = scale0; }
        const int col0 = colt + wc * 32 + 8 * fq, bcol0 = u.pn * BM + wc * 32 + 8 * fq;
        f32x4 bv[2][2];
#pragma unroll
        for (int bj = 0; bj < 2; ++bj)
#pragma unroll
            for (int n = 0; n < 2; ++n) bv[bj][n] = bias ? *(const f32x4*)(bias + bcol0 + bj * HALF + 4 * n) : (f32x4){0.f, 0.f, 0.f, 0.f};
#pragma unroll
        for (int ai = 0; ai < 2; ++ai)
#pragma unroll
            for (int m = 0; m < 4; ++m) { bf16_t* rowp = base + (size_t)(row0 + ai * HALF + m * 16) * ldc + col0;
#pragma unroll
                for (int bj = 0; bj < 2; ++bj) { f32x4 v0 = acc[ai][bj][m][0] + bv[bj][0], v1 = acc[ai][bj][m][1] + bv[bj][1];
                    if (ACT == 1) { f32x2 a = gelu_pk((f32x2){v0[0], v0[1]}), b = gelu_pk((f32x2){v0[2], v0[3]}), c = gelu_pk((f32x2){v1[0], v1[1]}), d = gelu_pk((f32x2){v1[2], v1[3]});
                        v0 = (f32x4){a.x, a.y, b.x, b.y}; v1 = (f32x4){c.x, c.y, d.x, d.y}; }
                    v0 = v0 * sc; v1 = v1 * sc; u32x4 w; w.x = cvt_pk_bf16(v0[0], v0[1]); w.y = cvt_pk_bf16(v0[2], v0[3]); w.z = cvt_pk_bf16(v1[0], v1[1]); w.w = cvt_pk_bf16(v1[2], v1[3]);
                    *(u32x4*)(rowp + bj * HALF) = w; } }
    }
};
struct EpiOut {
    static constexpr bool PERM = false, AFTER_DRAIN = false;
    const float* x; const float* gate; float* out; int ldc; int rows_per_batch; int gate_stride;
    __device__ __forceinline__ void operator()(const f32x4 (&acc)[2][2][4][2], const Unit& u, int wr, int wc, int fr, int fq) const {
        const int row0 = u.pm * BM + wr * 64 + fr, col0 = u.pn * BM + wc * 32 + 4 * fq;
        const float* gp = gate + (size_t)((u.pm * BM) / rows_per_batch) * gate_stride + col0;
        f32x4 gv[2][2];
#pragma unroll
        for (int bj = 0; bj < 2; ++bj)
#pragma unroll
            for (int n = 0; n < 2; ++n) gv[bj][n] = *(const f32x4*)(gp + bj * HALF + n * 16);
#pragma unroll
        for (int ai = 0; ai < 2; ++ai)
#pragma unroll
            for (int m = 0; m < 4; ++m) { const size_t off = (size_t)(row0 + ai * HALF + m * 16) * ldc + col0;
#pragma unroll
                for (int bj = 0; bj < 2; ++bj)
#pragma unroll
                    for (int n = 0; n < 2; ++n) { const f32x4 xv = __builtin_nontemporal_load((const f32x4*)(x + off + bj * HALF + n * 16));
                        __builtin_nontemporal_store(xv + gv[bj][n] * acc[ai][bj][m][n], (f32x4*)(out + off + bj * HALF + n * 16)); }
                asm volatile("" ::: "memory"); }
    }
};
struct EpiIn {
    static constexpr bool PERM = false, AFTER_DRAIN = false;
    bf16_t* O; int ldc;
    __device__ __forceinline__ void operator()(const f32x4 (&acc)[2][2][4][2], const Unit& u, int wr, int wc, int fr, int fq) const {
        const int row0 = u.pm * BM + wr * 64 + fr;
        if (u.pn < 16) {
            const int col = 8 * (u.pn * 16 + wc * 4 + fq);
#pragma unroll
            for (int ai = 0; ai < 2; ++ai)
#pragma unroll
                for (int m = 0; m < 4; ++m) { bf16_t* rowp = O + (size_t)(row0 + ai * HALF + m * 16) * ldc + col;
                    const f32x4 x = acc[ai][0][m][0], c = acc[ai][0][m][1], b = acc[ai][1][m][0], z = acc[ai][1][m][1];
                    f32x4 u2 = c * x, gz;
#pragma unroll
                    for (int e = 0; e < 4; ++e) gz[e] = b[e] * z[e] * __builtin_amdgcn_rcpf(1.f + __expf(-z[e]));
                    u32x4 w; w.x = cvt_pk_bf16(u2[0], u2[1]); w.y = cvt_pk_bf16(u2[2], u2[3]); w.z = cvt_pk_bf16(gz[0], gz[1]); w.w = cvt_pk_bf16(gz[2], gz[3]);
                    *(u32x4*)(rowp) = w; }
        } else {
            const int col0 = u.pn * BM + wc * 32 + 8 * fq;
            float z0 = 0.f; asm volatile("" : "+v"(z0)); const f32x4 zf = {z0, z0, z0, z0};
#pragma unroll
            for (int ai = 0; ai < 2; ++ai)
#pragma unroll
                for (int m = 0; m < 4; ++m) { bf16_t* rowp = O + (size_t)(row0 + ai * HALF + m * 16) * ldc + col0;
#pragma unroll
                    for (int bj = 0; bj < 2; ++bj) { const f32x4 v0 = acc[ai][bj][m][0] + zf, v1 = acc[ai][bj][m][1] + zf;
                        u32x4 w; w.x = cvt_pk_bf16(v0[0], v0[1]); w.y = cvt_pk_bf16(v0[2], v0[3]); w.z = cvt_pk_bf16(v1[0], v1[1]); w.w = cvt_pk_bf16(v1[2], v1[3]);
                        *(u32x4*)(rowp + bj * HALF) = w; } }
        }
    }
};
struct KvOrder {
    int nM, nN, nwg, G, c; bool bal;
    __host__ __device__ void init(int M, int N, int G_, int c_) { nM = M / BM; nN = N / BM; nwg = nM * nN; G = G_; c = c_; bal = (G_ == 256 && nwg == 512); }
    __host__ __device__ bool next(int i, Unit& u) const {
        long L;
        if (!bal) L = (long)i * G + c;
        else if (c < 128) L = (i == 0) ? c : -1;
        else L = (i == 0) ? c : (i == 1) ? 256 + 2 * (c - 128) : (i == 2) ? 257 + 2 * (c - 128) : -1;
        if (L < 0 || L >= nwg) return false;
        int wgid = (int)L; { const int q = nwg / NXCD, r = nwg % NXCD, xcd = wgid % NXCD, off = wgid / NXCD; wgid = (xcd < r ? xcd * (q + 1) : r * (q + 1) + (xcd - r) * q) + off; }
        const int nig = WGM * nN, gid = wgid / nig, fm = gid * WGM, gsz = (nM - fm) < WGM ? (nM - fm) : WGM;
        u.pm = fm + ((wgid % nig) % gsz); u.pn = (wgid % nig) / gsz; return true;
    }
    __device__ __forceinline__ void a_ready(const Unit&) const {}
    __device__ __forceinline__ void done(const Unit&) const {}
};
template <class Epi, class Sched, bool ALIGN_EPI = false, bool SP2 = false>
__device__ __forceinline__ void gemm_phase(PG8_LAS unsigned char* lds, const Gemm g, const Sched& S, const Epi& E) {
    const int tid = threadIdx.x, wid = __builtin_amdgcn_readfirstlane(tid >> 6), lane = tid & 63, wr = wid >> 2, wc = wid & 3, fr = lane & 15, fq = lane >> 4;
    const int K = g.K, nt = K / BK;
    unsigned voffA[2], voffB[2];
#pragma unroll
    for (int i = 0; i < 2; ++i) { int R, C; stage_rc(tid * 16 + i * 8192, R, C); const int Rb = Epi::PERM ? ((R & ~31) + perm32(R & 31)) : R;
        voffA[i] = (unsigned)(R * K + C) * 2u; voffB[i] = (unsigned)(Rb * K + C) * 2u; }
    const size_t kstep = (size_t)(BK * 2);
    const size_t hstep = (size_t)HALF * K * 2;
    const size_t tstep = 2 * hstep;
    const unsigned ldsw = (unsigned)wid * 1024u;
    const int aoff = lds_byte(wr * 64 + fr, fq * 8), boff = lds_byte(wc * 32 + fr, fq * 8);
#define PG8_SA(b, h) (((b) * 2 + (h)) * HTB)
#define PG8_SB(b, h) ((4 + (b) * 2 + (h)) * HTB)
#define PG8_STAGE(bufoff, gbase, voff) do { _Pragma("unroll") for (int _i = 0; _i < 2; ++_i) \
        __builtin_amdgcn_global_load_lds((const unsigned*)((const char*)(gbase) + (voff)[_i]), (PG8_LAS unsigned*)(lds + (bufoff) + ldsw + _i * 8192), 16, 0, 0); } while (0)
#define PG8_LDA(dst, b, h) do { _Pragma("unroll") for (int m = 0; m < 4; ++m) _Pragma("unroll") for (int k = 0; k < 2; ++k) dst[m][k] = *(const PG8_LAS bf16x8*)(lds + PG8_SA(b, h) + aoff + m * 2048 + k * 1024); } while (0)
#define PG8_LDB(dst, b, h) do { _Pragma("unroll") for (int n = 0; n < 2; ++n) _Pragma("unroll") for (int k = 0; k < 2; ++k) dst[n][k] = *(const PG8_LAS bf16x8*)(lds + PG8_SB(b, h) + boff + n * 2048 + k * 1024); } while (0)
#define PG8_MMA(ai, bj, At, Bt) do { __builtin_amdgcn_s_setprio(1); _Pragma("unroll") for (int m = 0; m < 4; ++m) _Pragma("unroll") for (int n = 0; n < 2; ++n) _Pragma("unroll") for (int k = 0; k < 2; ++k) \
        acc[ai][bj][m][n] = __builtin_amdgcn_mfma_f32_16x16x32_bf16(Bt[n][k], At[m][k], acc[ai][bj][m][n], 0, 0, 0); __builtin_amdgcn_s_setprio(0); } while (0)
#define PG8_WAIT_V(n) asm volatile("s_waitcnt vmcnt(" #n ")" ::: "memory")
#define PG8_WAIT_L(n) asm volatile("s_waitcnt lgkmcnt(" #n ")" ::: "memory")
#define PG8_BAR __builtin_amdgcn_s_barrier()
#define PG8_SCHED __builtin_amdgcn_sched_barrier(0)
    Unit cur, nxt; int ui = 0;
    if (!S.next(0, cur)) return;
    f32x4 acc[2][2][4][2];
#pragma unroll
    for (int a = 0; a < 2; ++a)
#pragma unroll
        for (int b = 0; b < 2; ++b)
#pragma unroll
            for (int m = 0; m < 4; ++m)
#pragma unroll
                for (int n = 0; n < 2; ++n) acc[a][b][m][n] = (f32x4){0.f, 0.f, 0.f, 0.f};
    bf16x8 At[4][2], B0[2][2], B1[2][2];
    const char* cA = (const char*)g.A + (size_t)cur.pm * tstep; const char* cB = (const char*)g.Bt + (size_t)cur.pn * tstep;
    S.a_ready(cur);
    if constexpr (SP2) {
        PG8_STAGE(PG8_SB(0, 0), cB, voffB); PG8_STAGE(PG8_SB(0, 1), cB + hstep, voffB); PG8_STAGE(PG8_SA(0, 0), cA, voffA); PG8_STAGE(PG8_SA(0, 1), cA + hstep, voffA);
        if (wr == 1) PG8_BAR;
        PG8_WAIT_V(2); PG8_BAR;
        PG8_STAGE(PG8_SB(1, 0), cB + kstep, voffB); PG8_STAGE(PG8_SA(1, 0), cA + kstep, voffA); PG8_STAGE(PG8_SB(1, 1), cB + hstep + kstep, voffB);
        PG8_WAIT_V(6); PG8_BAR;
    } else {
        PG8_STAGE(PG8_SB(0, 0), cB, voffB); PG8_STAGE(PG8_SA(0, 0), cA, voffA); PG8_STAGE(PG8_SB(0, 1), cB + hstep, voffB); PG8_STAGE(PG8_SA(0, 1), cA + hstep, voffA);
        if (wr == 1) PG8_BAR;
        PG8_WAIT_V(4); PG8_BAR;
        PG8_STAGE(PG8_SB(1, 0), cB + kstep, voffB); PG8_STAGE(PG8_SA(1, 0), cA + kstep, voffA); PG8_STAGE(PG8_SB(1, 1), cB + hstep + kstep, voffB);
        PG8_WAIT_V(6); PG8_BAR;
    }
    for (;;) {
        const bool has_next = S.next(ui + 1, nxt);
        const char* nA = has_next ? (const char*)g.A + (size_t)nxt.pm * tstep : cA; const char* nB = has_next ? (const char*)g.Bt + (size_t)nxt.pn * tstep : cB;
        for (int t = 0; t < nt; t += 2) {
            const bool last = (t == nt - 2);
            const char* a1 = cA + (size_t)(t + 1) * kstep;
            const char* a2 = last ? nA : cA + (size_t)(t + 2) * kstep; const char* b2 = last ? nB : cB + (size_t)(t + 2) * kstep;
            const char* a3 = a2 + kstep; const char* b3 = b2 + kstep;
            if (last && has_next) S.a_ready(nxt);
            if constexpr (SP2) {
            PG8_LDB(B0, 0, 0); PG8_LDB(B1, 0, 1); PG8_SCHED; PG8_LDA(At, 0, 0); PG8_STAGE(PG8_SA(1, 1), a1 + hstep, voffA);
            PG8_WAIT_V(8); PG8_WAIT_L(0); PG8_BAR; PG8_MMA(0, 0, At, B0); PG8_MMA(0, 1, At, B1); PG8_BAR; PG8_SCHED;
            PG8_LDA(At, 0, 1); PG8_STAGE(PG8_SB(0, 0), b2, voffB); PG8_STAGE(PG8_SB(0, 1), b2 + hstep, voffB); PG8_STAGE(PG8_SA(0, 0), a2, voffA);
            PG8_WAIT_V(8); PG8_WAIT_L(0); PG8_BAR; PG8_MMA(1, 0, At, B0); PG8_MMA(1, 1, At, B1); PG8_BAR; PG8_SCHED;
            PG8_LDB(B0, 1, 0); PG8_LDB(B1, 1, 1); PG8_SCHED; PG8_LDA(At, 1, 0); PG8_STAGE(PG8_SA(0, 1), a2 + hstep, voffA);
            PG8_WAIT_V(8); PG8_WAIT_L(0); PG8_BAR; PG8_MMA(0, 0, At, B0); PG8_MMA(0, 1, At, B1); PG8_BAR; PG8_SCHED;
            PG8_LDA(At, 1, 1); PG8_STAGE(PG8_SB(1, 0), b3, voffB); PG8_STAGE(PG8_SB(1, 1), b3 + hstep, voffB); PG8_STAGE(PG8_SA(1, 0), a3, voffA);
            PG8_WAIT_V(8); PG8_WAIT_L(0); PG8_BAR; PG8_MMA(1, 0, At, B0); PG8_MMA(1, 1, At, B1); PG8_BAR; PG8_SCHED;
            } else {
            PG8_LDB(B0, 0, 0); PG8_SCHED; PG8_LDA(At, 0, 0); PG8_STAGE(PG8_SA(1, 1), a1 + hstep, voffA);
            PG8_WAIT_L(8); PG8_BAR; PG8_WAIT_L(0); PG8_MMA(0, 0, At, B0); PG8_BAR; PG8_SCHED;
            PG8_LDB(B1, 0, 1); PG8_STAGE(PG8_SB(0, 0), b2, voffB);
            PG8_BAR; PG8_WAIT_L(0); PG8_MMA(0, 1, At, B1); PG8_BAR;
            PG8_LDA(At, 0, 1); PG8_STAGE(PG8_SA(0, 0), a2, voffA);
            PG8_BAR; PG8_WAIT_L(0); PG8_MMA(1, 0, At, B0); PG8_BAR; PG8_SCHED;
            PG8_STAGE(PG8_SB(0, 1), b2 + hstep, voffB);
            PG8_WAIT_V(6); PG8_BAR; PG8_MMA(1, 1, At, B1); PG8_BAR;
            PG8_LDB(B0, 1, 0); PG8_SCHED; PG8_LDA(At, 1, 0); PG8_STAGE(PG8_SA(0, 1), a2 + hstep, voffA);
            PG8_WAIT_L(8); PG8_BAR; PG8_WAIT_L(0); PG8_MMA(0, 0, At, B0); PG8_BAR; PG8_SCHED;
            PG8_LDB(B1, 1, 1); PG8_STAGE(PG8_SB(1, 0), b3, voffB);
            PG8_BAR; PG8_WAIT_L(0); PG8_MMA(0, 1, At, B1); PG8_BAR;
            PG8_LDA(At, 1, 1); PG8_STAGE(PG8_SA(1, 0), a3, voffA);
            PG8_BAR; PG8_WAIT_L(0); PG8_MMA(1, 0, At, B0); PG8_BAR; PG8_SCHED;
            PG8_STAGE(PG8_SB(1, 1), b3 + hstep, voffB);
            PG8_WAIT_V(6); PG8_BAR; PG8_MMA(1, 1, At, B1); PG8_BAR;
            }
        }
        if constexpr (ALIGN_EPI) { if (wr == 0) PG8_BAR; }
        if constexpr (!Epi::AFTER_DRAIN) { E(acc, cur, wr, wc, fr, fq); S.done(cur); }
        if (!has_next) break;
#pragma unroll
        for (int a = 0; a < 2; ++a)
#pragma unroll
            for (int b = 0; b < 2; ++b)
#pragma unroll
                for (int m = 0; m < 4; ++m)
#pragma unroll
                    for (int n = 0; n < 2; ++n) acc[a][b][m][n] = (f32x4){0.f, 0.f, 0.f, 0.f};
        cur = nxt; cA = nA; cB = nB; ++ui;
        if constexpr (ALIGN_EPI) { if (wr == 1) PG8_BAR; }
    }
    PG8_WAIT_V(0);
    if constexpr (!ALIGN_EPI) { if (wr == 0) PG8_BAR; }
    PG8_BAR;
    if constexpr (Epi::AFTER_DRAIN) { E.fused(acc, cur, wr, wc, fr, fq, lds, wid, lane); S.done(cur); }
#undef PG8_SA
#undef PG8_SB
#undef PG8_STAGE
#undef PG8_LDA
#undef PG8_LDB
#undef PG8_MMA
#undef PG8_WAIT_V
#undef PG8_WAIT_L
#undef PG8_BAR
#undef PG8_SCHED
}
}
namespace att {
using bf16 = __hip_bfloat16;
typedef short bf16x8 __attribute__((ext_vector_type(8)));
typedef short s16x4 __attribute__((ext_vector_type(4)));
typedef float f32x16 __attribute__((ext_vector_type(16)));
typedef float f32x4 __attribute__((ext_vector_type(4)));
typedef unsigned u32x4 __attribute__((ext_vector_type(4)));
constexpr int SEQ = 8192, NH = 8, DQK = 192, DV = 128;
constexpr int NW = 8, QBLK = 32, KVBLK = 32, QB = NW * QBLK;
constexpr int SUB_V = KVBLK * DV * 2, SUB_K = KVBLK * 528;
constexpr int SHM_V = 2 * SUB_V, SHM_K = 2 * SUB_K, NVS = 3, NKS = 2;
constexpr int LDS_K0 = NVS * SHM_V, LDS_WS = LDS_K0 + NKS * SHM_K, LDS_BYTES = LDS_WS + NW * 64 * 4;
constexpr float SCALE = 0.07216878364870322f;
constexpr float THR2 = 11.5415603f;
constexpr int Q_PITCH = 1536, KV_PITCH = 2048, U_PITCH = 6144, Y_PITCH = 2048, ZA_OFF = 4928, YA_OFF = 1024;

#define KADDR(row, colB) ((row) * 528 + (colB))
#define SBAR() __builtin_amdgcn_sched_barrier(0)
__device__ __forceinline__ int v_st(int k, int c) { const int kk = (k & ~0xC) | ((k & 4) << 1) | ((k & 8) >> 1); return ((kk >> 3) * 4 + (c >> 5)) * 512 + ((kk & 7) * 32 + (c & 31)) * 2; }
__device__ __forceinline__ int v_rd_base(int lane) { return ((lane & 3) << 3) | (((lane >> 2) & 3) << 6) | (((lane >> 4) & 1) << 5) | (((lane >> 5) & 1) << 8); }
constexpr int v_rd_off(int d0, int ks, int half) { return d0 * 512 + ks * 4096 + half * 2048; }
__device__ __forceinline__ int crow(int r, int hi) { return (r & 3) + 8 * (r >> 2) + 4 * hi; }
__device__ __forceinline__ unsigned cvtpk(float lo, float hi) {
    unsigned r; asm volatile("s_nop 0\n\tv_cvt_pk_bf16_f32 %0, %1, %2" : "=v"(r) : "v"(lo), "v"(hi)); return r;
}
__device__ __forceinline__ void cvtpk4(unsigned& a0, unsigned& a1, unsigned& b0, unsigned& b1, float x0, float x1, float x2, float x3, float x4, float x5, float x6, float x7) {
    asm volatile("s_nop 0\n\tv_cvt_pk_bf16_f32 %0, %4, %5\n\tv_cvt_pk_bf16_f32 %1, %6, %7\n\tv_cvt_pk_bf16_f32 %2, %8, %9\n\tv_cvt_pk_bf16_f32 %3, %10, %11"
                 : "=&v"(a0), "=&v"(a1), "=&v"(b0), "=&v"(b1) : "v"(x0), "v"(x1), "v"(x2), "v"(x3), "v"(x4), "v"(x5), "v"(x6), "v"(x7));
}
__device__ __forceinline__ void mask_tile(f32x16& p0, int dq) {
    const float NEG = -__builtin_inff();
#pragma unroll
    for (int r = 0; r < 16; ++r) { const int c = (r & 3) + 8 * (r >> 2); if (dq - c < 0) p0[r] = NEG; }
}
__device__ __forceinline__ void partialSM(f32x16& p0, float& m_reg, float& alpha) {
    float pmax = fmaxf(p0[0], p0[1]);
#pragma unroll
    for (int r = 2; r < 16; ++r) pmax = fmaxf(pmax, p0[r]);
    { auto rr = __builtin_amdgcn_permlane32_swap(__float_as_uint(pmax), __float_as_uint(pmax), false, false);
      pmax = fmaxf(__uint_as_float(rr[0]), __uint_as_float(rr[1])); }
    float mn;
    if (__builtin_expect(__all((pmax - m_reg) <= THR2), 1)) { mn = m_reg; alpha = 1.f; }
    else { mn = fmaxf(m_reg, pmax); alpha = __builtin_amdgcn_exp2f(m_reg - mn); m_reg = mn; }
#pragma unroll
    for (int r = 0; r < 16; ++r) p0[r] = p0[r] - mn;
}
#define PK4(P, B_, OUT) do { unsigned a0, a1, b0, b1; cvtpk4(a0, a1, b0, b1, P[B_+0], P[B_+1], P[B_+2], P[B_+3], P[B_+4], P[B_+5], P[B_+6], P[B_+7]); \
        auto r0 = __builtin_amdgcn_permlane32_swap(a0, b0, false, false); auto r1 = __builtin_amdgcn_permlane32_swap(a1, b1, false, false); \
        u32x4 w = {r0[0], r1[0], r0[1], r1[1]}; OUT = __builtin_bit_cast(bf16x8, w); } while (0)
__device__ __forceinline__ void finishSM(f32x16& p0, float alpha, float& l_reg, bf16x8& pa0, bf16x8& pa1) {
#pragma unroll
    for (int r = 0; r < 16; ++r) p0[r] = __builtin_amdgcn_exp2f(p0[r]);
    float ps = 0;
#pragma unroll
    for (int r = 0; r < 16; ++r) ps += p0[r];
    { auto rr = __builtin_amdgcn_permlane32_swap(__float_as_uint(ps), __float_as_uint(ps), false, false);
      ps = __uint_as_float(rr[0]) + __uint_as_float(rr[1]); }
    l_reg = l_reg * alpha + ps;
    PK4(p0, 0, pa0); PK4(p0, 8, pa1);
}
__device__ __forceinline__ void finishFast(f32x16& p0, float& l_half, bf16x8& pa0, bf16x8& pa1) {
#pragma unroll
    for (int r = 0; r < 16; ++r) p0[r] = __builtin_amdgcn_exp2f(p0[r]);
    float ps0 = p0[0] + p0[1], ps1 = p0[2] + p0[3];
#pragma unroll
    for (int r = 4; r < 16; r += 4) { ps0 += p0[r] + p0[r + 1]; ps1 += p0[r + 2] + p0[r + 3]; }
    l_half += ps0 + ps1;
    PK4(p0, 0, pa0); PK4(p0, 8, pa1);
}
#undef PK4
#define KRD(dst, addr, off) asm volatile("ds_read_b128 %0, %1 offset:%2" : "=&v"(dst) : "v"(addr), "i"(off) : "memory")
#define KWT(n, f) asm volatile("s_waitcnt lgkmcnt(" #n ")" : "+v"(f) :: "memory")
__device__ __forceinline__ void qkt(f32x16& p0, int ka, const bf16x8* qr) {
    bf16x8 f0, f1, f2;
    KRD(f0, ka, 0); KRD(f1, ka, 32);
    p0 = f32x16{};
    KRD(f2, ka, 64);  KWT(2, f0); p0 = __builtin_amdgcn_mfma_f32_32x32x16_bf16(f0, qr[0], p0, 0, 0, 0);
    KRD(f0, ka, 96);  KWT(2, f1); p0 = __builtin_amdgcn_mfma_f32_32x32x16_bf16(f1, qr[1], p0, 0, 0, 0);
    KRD(f1, ka, 128); KWT(2, f2); p0 = __builtin_amdgcn_mfma_f32_32x32x16_bf16(f2, qr[2], p0, 0, 0, 0);
    KRD(f2, ka, 160); KWT(2, f0); p0 = __builtin_amdgcn_mfma_f32_32x32x16_bf16(f0, qr[3], p0, 0, 0, 0);
    KRD(f0, ka, 192); KWT(2, f1); p0 = __builtin_amdgcn_mfma_f32_32x32x16_bf16(f1, qr[4], p0, 0, 0, 0);
    KRD(f1, ka, 224); KWT(2, f2); p0 = __builtin_amdgcn_mfma_f32_32x32x16_bf16(f2, qr[5], p0, 0, 0, 0);
    KRD(f2, ka, 256); KWT(2, f0); p0 = __builtin_amdgcn_mfma_f32_32x32x16_bf16(f0, qr[6], p0, 0, 0, 0);
    KRD(f0, ka, 288); KWT(2, f1); p0 = __builtin_amdgcn_mfma_f32_32x32x16_bf16(f1, qr[7], p0, 0, 0, 0);
    KRD(f1, ka, 320); KWT(2, f2); p0 = __builtin_amdgcn_mfma_f32_32x32x16_bf16(f2, qr[8], p0, 0, 0, 0);
    KRD(f2, ka, 352); KWT(2, f0); p0 = __builtin_amdgcn_mfma_f32_32x32x16_bf16(f0, qr[9], p0, 0, 0, 0);
    KWT(1, f1); p0 = __builtin_amdgcn_mfma_f32_32x32x16_bf16(f1, qr[10], p0, 0, 0, 0);
    KWT(0, f2); p0 = __builtin_amdgcn_mfma_f32_32x32x16_bf16(f2, qr[11], p0, 0, 0, 0);
}
#undef KRD
#undef KWT
__device__ __forceinline__ void pv_tile(f32x16* o, int vb, bf16x8 pa0, bf16x8 pa1) {
#define TRRD(dst, off) asm volatile("ds_read_b64_tr_b16 %0, %1 offset:%2" : "=&v"(dst) : "v"(vb), "i"(off) : "memory")
#define PV_RD(S_, d0) do { TRRD(S_##l0, v_rd_off(d0, 0, 0)); TRRD(S_##h0, v_rd_off(d0, 0, 1)); TRRD(S_##l1, v_rd_off(d0, 1, 0)); TRRD(S_##h1, v_rd_off(d0, 1, 1)); } while (0)
#define PV_WT(n, S_) asm volatile("s_waitcnt lgkmcnt(" #n ")" : "+v"(S_##l0), "+v"(S_##h0), "+v"(S_##l1), "+v"(S_##h1) :: "memory")
#define PV_MM(S_, d0) do { \
        o[d0] = __builtin_amdgcn_mfma_f32_32x32x16_bf16(pa0, (bf16x8){S_##l0[0], S_##l0[1], S_##l0[2], S_##l0[3], S_##h0[0], S_##h0[1], S_##h0[2], S_##h0[3]}, o[d0], 0, 0, 0); \
        o[d0] = __builtin_amdgcn_mfma_f32_32x32x16_bf16(pa1, (bf16x8){S_##l1[0], S_##l1[1], S_##l1[2], S_##l1[3], S_##h1[0], S_##h1[1], S_##h1[2], S_##h1[3]}, o[d0], 0, 0, 0); } while (0)
    s16x4 al0, ah0, al1, ah1, bl0, bh0, bl1, bh1;
    PV_RD(a, 0); PV_RD(b, 1);
    PV_WT(4, a); PV_MM(a, 0);
    PV_RD(a, 2); PV_WT(4, b); PV_MM(b, 1);
    PV_RD(b, 3); PV_WT(4, a); PV_MM(a, 2);
    PV_WT(0, b); PV_MM(b, 3);
#undef PV_MM
#undef PV_WT
#undef PV_RD
#undef TRRD
}
__device__ __forceinline__ float bf2f(unsigned short v) { return __uint_as_float((unsigned)v << 16); }

constexpr int LDS_OST = LDS_K0, OST_WAVE = 8192;
static_assert(NW * OST_WAVE <= NKS * SHM_K, "O stage must fit inside the K ring");
template <bool FAST>
__device__ __forceinline__ void attn_unit(int b, int h, int qb, const bf16* __restrict__ QN, const bf16* __restrict__ KF, const bf16* __restrict__ KV,
                                          const bf16* __restrict__ U, bf16* __restrict__ Y, const float* __restrict__ q_g, const int* __restrict__ posv, const float* __restrict__ invf32, char* lds) {
    const int tid = threadIdx.x, wid = __builtin_amdgcn_readfirstlane(tid >> 6), lane = tid & 63, r32 = lane & 31, hi = lane >> 5;
    const int P0 = qb * QB, NT = (P0 + QB) / KVBLK;
    const size_t row0 = (size_t)b * SEQ;
    char* V_lds = lds; char* K_lds = lds + LDS_K0;
    float* ws = (float*)(lds + LDS_WS) + wid * 64; float* li_l = ws; float* al_l = ws + 32; const float* al_h = al_l + 4 * hi;
    bf16x8 qr[12];
    { const size_t qrow = row0 + P0 + wid * QBLK + r32;
      const bf16* Qw = QN + qrow * Q_PITCH + h * DQK + hi * 8;
#pragma unroll
      for (int d0 = 0; d0 < 12; ++d0) qr[d0] = *reinterpret_cast<const bf16x8*>(Qw + d0 * 16);
      const float pos = (float)posv[qrow];
      int go = hi * 8; asm volatile("" : "+v"(go));
      float ss = 0.f;
#pragma unroll
      for (int d0 = 0; d0 < 12; ++d0) {
#pragma unroll
          for (int e = 0; e < 8; ++e) { const float x = bf2f((unsigned short)qr[d0][e]); ss += x * x; } }
      { auto rr = __builtin_amdgcn_permlane32_swap(__float_as_uint(ss), __float_as_uint(ss), false, false); ss = __uint_as_float(rr[0]) + __uint_as_float(rr[1]); }
      constexpr float QS = 0.07216878364870322f * 1.4426950408889634f;
      const float rs = QS / sqrtf(ss * (1.f / DQK) + 1e-6f);
#pragma unroll
      for (int d0 = 0; d0 < 8; ++d0) { const f32x4 ga = *(const f32x4*)(q_g + d0 * 16 + go), gb = *(const f32x4*)(q_g + d0 * 16 + go + 4);
          const float g8[8] = {ga[0], ga[1], ga[2], ga[3], gb[0], gb[1], gb[2], gb[3]}; u32x4 w;
#pragma unroll
          for (int e = 0; e < 4; ++e) w[e] = cvtpk(bf2f((unsigned short)qr[d0][2 * e]) * rs * g8[2 * e], bf2f((unsigned short)qr[d0][2 * e + 1]) * rs * g8[2 * e + 1]);
          qr[d0] = __builtin_bit_cast(bf16x8, w); }
#pragma unroll
      for (int j = 0; j < 2; ++j) {
          const f32x4 ga = *(const f32x4*)(q_g + (8 + j) * 16 + go), gb = *(const f32x4*)(q_g + (8 + j) * 16 + go + 4);
          const f32x4 gc = *(const f32x4*)(q_g + (10 + j) * 16 + go), gd = *(const f32x4*)(q_g + (10 + j) * 16 + go + 4);
          const f32x4 fa = *(const f32x4*)(invf32 + 16 * j + go), fb = *(const f32x4*)(invf32 + 16 * j + go + 4);
          const float g1[8] = {ga[0], ga[1], ga[2], ga[3], gb[0], gb[1], gb[2], gb[3]}, g2[8] = {gc[0], gc[1], gc[2], gc[3], gd[0], gd[1], gd[2], gd[3]};
          const float fq8[8] = {fa[0], fa[1], fa[2], fa[3], fb[0], fb[1], fb[2], fb[3]};
          float o1[8], o2[8];
#pragma unroll
          for (int e = 0; e < 8; ++e) { const float ang = pos * fq8[e]; double rev = (double)ang * 0.15915494309189535; rev -= __builtin_rint(rev); const float fr = (float)rev;
              const float cs = __builtin_amdgcn_cosf(fr), sn = __builtin_amdgcn_sinf(fr);
              const float y1 = bf2f((unsigned short)qr[8 + j][e]) * rs * g1[e], y2 = bf2f((unsigned short)qr[10 + j][e]) * rs * g2[e];
              o1[e] = y1 * cs - y2 * sn; o2[e] = y1 * sn + y2 * cs; }
          u32x4 w1, w2;
#pragma unroll
          for (int e = 0; e < 4; ++e) { w1[e] = cvtpk(o1[2 * e], o1[2 * e + 1]); w2[e] = cvtpk(o2[2 * e], o2[2 * e + 1]); }
          qr[8 + j] = __builtin_bit_cast(bf16x8, w1); qr[10 + j] = __builtin_bit_cast(bf16x8, w2); } }
    const char* Kbase = (const char*)(KF + ((size_t)(b * NH + h) * SEQ) * DQK);
    const int sr = tid >> 4, sc = (tid & 15) * 8;
    const char* Vbase = (const char*)(KV + row0 * KV_PITCH + h * 256 + 128);
    const unsigned koff = (unsigned)tid * 16u, voff = (unsigned)(sr * KV_PITCH + sc) * 2u;
    const bool k2 = tid < 256;
    int kws0, kws1;
    { int e = tid, row = e / 24, c = e - row * 24; kws0 = KADDR(row, c * 16); e = tid + 512; row = e / 24; c = e - row * 24; kws1 = KADDR(row, c * 16); }
    const int vst0 = v_st(sr, sc);
    const int vb0 = (int)(uintptr_t)V_lds + v_rd_base(lane); const int kl0 = (int)(uintptr_t)K_lds + KADDR(r32, hi * 16);
    bf16x8 st_k0, st_k1, st_v0;
#define KOFF(j) ((((j) >> 1) & 1) * SHM_K + ((j) & 1) * SUB_K)
#define VOFF(j) ((((j) >> 1) % 3) * SHM_V + ((j) & 1) * SUB_V)
#define SLOAD(t) do { const char* kp_ = Kbase + (size_t)(t) * (KVBLK * DQK * 2); const char* vp_ = Vbase + (size_t)(t) * (KVBLK * KV_PITCH * 2); \
        st_k0 = *reinterpret_cast<const bf16x8*>(kp_ + koff); if (k2) st_k1 = *reinterpret_cast<const bf16x8*>(kp_ + koff + 8192u); \
        st_v0 = *reinterpret_cast<const bf16x8*>(vp_ + voff); } while (0)
#define SWRITE(j) do { const int ko_ = KOFF(j), vo_ = VOFF(j); *(bf16x8*)(K_lds + ko_ + kws0) = st_k0; if (k2) *(bf16x8*)(K_lds + ko_ + kws1) = st_k1; \
        *(bf16x8*)(V_lds + vo_ + vst0) = st_v0; } while (0)
#define VMW() asm volatile("s_waitcnt vmcnt(0)" ::: "memory")
    const int qlo = P0 + wid * QBLK, qm = qlo + r32 - 4 * hi;
    float m_reg = -1e30f, l_reg = 0.f; f32x16 o[4] = {};
    f32x16 pA, pB; float al = 1.f; bf16x8 pa0, pa1;
#define RESC(a) do { if (__any((a) < 1.f)) { if (hi == 0) al_l[r32] = (a); asm volatile("s_waitcnt lgkmcnt(0)" ::: "memory");              \
        _Pragma("unroll") for (int d_ = 0; d_ < 4; ++d_) _Pragma("unroll") for (int r = 0; r < 16; ++r) o[d_][r] *= al_h[(r & 3) + 8 * (r >> 2)]; \
        asm volatile("s_waitcnt lgkmcnt(0)" ::: "memory"); } } while (0)
#define MASKT(P_, t) do { const int kb_ = (t) * KVBLK; if (kb_ + KVBLK - 1 > qlo) { int dq_ = qm - kb_; asm volatile("" : "+v"(dq_)); mask_tile(P_, dq_); } } while (0)
#define STEP(PX, PY, t, MASKED) do { \
        SBAR(); qkt(PX, kl0 + KOFF(t), qr); \
        if constexpr (FAST) { finishFast(PY, l_reg, pa0, pa1); asm volatile("" : "+v"(l_reg)); SBAR(); } \
        else { finishSM(PY, al, l_reg, pa0, pa1); SBAR(); RESC(al); SBAR(); } \
        if ((t) + 2 < NT) { VMW(); SWRITE((t) + 2); } \
        if ((t) + 3 < NT) SLOAD((t) + 3); \
        SBAR(); \
        pv_tile(o, vb0 + VOFF((t) - 1), pa0, pa1); \
        if (MASKED) MASKT(PX, t); \
        if constexpr (!FAST) partialSM(PX, m_reg, al); \
        SBAR(); \
        if ((t) & 1) __syncthreads(); } while (0)
    SLOAD(0); VMW(); SWRITE(0); SLOAD(1); VMW(); SWRITE(1); SLOAD(2); __syncthreads();
    qkt(pA, kl0, qr); if (NT == 8) MASKT(pA, 0); if constexpr (!FAST) partialSM(pA, m_reg, al);
    VMW(); SWRITE(2); SLOAD(3);
    int t = 1;
    for (; t + 1 < NT - 8; t += 2) {
        STEP(pB, pA, t, false);
        STEP(pA, pB, t + 1, false);
    }
    for (; t + 1 < NT; t += 2) {
        STEP(pB, pA, t, true);
        STEP(pA, pB, t + 1, true);
    }
    STEP(pB, pA, t, true);
    if constexpr (FAST) { finishFast(pB, l_reg, pa0, pa1); } else { finishSM(pB, al, l_reg, pa0, pa1); RESC(al); }
    SBAR();
    pv_tile(o, vb0 + VOFF(NT - 1), pa0, pa1);
    if constexpr (FAST) { auto rr = __builtin_amdgcn_permlane32_swap(__float_as_uint(l_reg), __float_as_uint(l_reg), false, false); l_reg = __uint_as_float(rr[0]) + __uint_as_float(rr[1]); }
    if (hi == 0) li_l[r32] = l_reg; asm volatile("s_waitcnt lgkmcnt(0)" ::: "memory");
    int h4 = 4 * hi; asm volatile("" : "+v"(h4));
    const float* li_h = li_l + h4;
    unsigned short* stg = (unsigned short*)(lds + LDS_OST + wid * OST_WAVE) + h4 * 128 + r32;
#pragma unroll
    for (int r = 0; r < 16; ++r) { const int cr = (r & 3) + 8 * (r >> 2); const float rl = __builtin_amdgcn_rcpf(li_h[cr]);
#pragma unroll
        for (int d0 = 0; d0 < 4; ++d0) stg[cr * 128 + d0 * 32] = (unsigned short)(cvtpk(o[d0][r] * rl, 0.f) & 0xffffu); }
    asm volatile("s_waitcnt lgkmcnt(0)" ::: "memory");
    { const int ch = lane & 15, rsub = lane >> 4;
      const size_t mrow0 = row0 + P0 + wid * QBLK + rsub;
      const unsigned short* sg = (const unsigned short*)(lds + LDS_OST + wid * OST_WAVE) + rsub * 128 + ch * 8;
      const unsigned short* zp = reinterpret_cast<const unsigned short*>(U) + mrow0 * U_PITCH + ZA_OFF + h * DV + ch * 8;
      unsigned short* yp = reinterpret_cast<unsigned short*>(Y) + mrow0 * Y_PITCH + YA_OFF + h * DV + ch * 8;
#pragma unroll
      for (int i = 0; i < 8; ++i) { const u32x4 ov = *reinterpret_cast<const u32x4*>(sg + i * 4 * 128); const u32x4 zv = *reinterpret_cast<const u32x4*>(zp + (size_t)i * 4 * U_PITCH);
          u32x4 w;
#pragma unroll
          for (int e = 0; e < 4; ++e) { const float z0 = __uint_as_float(zv[e] << 16), z1 = __uint_as_float(zv[e] & 0xffff0000u);
              const float a0 = __uint_as_float(ov[e] << 16), a1 = __uint_as_float(ov[e] & 0xffff0000u);
              w[e] = cvtpk(a0 * z0 * __builtin_amdgcn_rcpf(1.f + __expf(-z0)), a1 * z1 * __builtin_amdgcn_rcpf(1.f + __expf(-z1))); }
          *reinterpret_cast<u32x4*>(yp + (size_t)i * 4 * Y_PITCH) = w; } }
    __syncthreads();
#undef SLOAD
#undef SWRITE
#undef VMW
#undef RESC
#undef MASKT
#undef KOFF
#undef VOFF
#undef STEP
}
#undef SBAR
}
constexpr int BATCH = 2, SEQ = 8192, DM = 2048, M = BATCH * SEQ;
constexpr int D_CONV = 1024, NHEAD = 8, QK_NOPE = 128, QK_ROPE = 64, QK_HEAD = 192, V_HEAD = 128, D_ATTN = 1024, Q_LORA = 512, KV_LORA = 256;
constexpr int IN_COLS = 5952, IN_PAD = 6144, NQ = NHEAD * QK_HEAD  , NKV = NHEAD * (QK_NOPE + V_HEAD)  ;
constexpr int OFF_XC = 0, OFF_BC = 1024, OFF_CC = 2048, OFF_ZC = 3072, OFF_CQ = 4096, OFF_CKV = 4608, OFF_KR = 4864, OFF_ZA = 4928;
constexpr float EPS = 1e-6f;
constexpr size_t MiB = 1u << 20;
constexpr size_t WS_WIN = 1 * MiB, WS_WQ = 26 * MiB, WS_WKV = 28 * MiB, WS_WOUT = 30 * MiB, WS_MOD = 39 * MiB;
constexpr size_t WS_H = 40 * MiB  , WS_U = 104 * MiB  , WS_CQN = 296 * MiB  , WS_CKVN = 312 * MiB  ;
constexpr size_t WS_QRAW = 320 * MiB  , WS_KVRAW = 368 * MiB  , WS_KF = 432 * MiB  , WS_END = 480 * MiB;
constexpr int NWAVES = 8, NTHREADS = 512;
constexpr int LDS_BYTES = 147456;

#define LAS __attribute__((address_space(3)))
typedef unsigned short bf16r;
typedef unsigned v4u __attribute__((ext_vector_type(4)));
typedef float f32x4 __attribute__((ext_vector_type(4)));
__device__ __forceinline__ unsigned f2bf(float f) { unsigned u = __builtin_bit_cast(unsigned, f); return (u + 0x7fffu + ((u >> 16) & 1u)) >> 16; }
__device__ __forceinline__ unsigned pk2(float lo, float hi) { return f2bf(lo) | (f2bf(hi) << 16); }
__device__ __forceinline__ float bfl(unsigned w) { return __uint_as_float(w << 16); }
__device__ __forceinline__ float bfh(unsigned w) { return __uint_as_float(w & 0xffff0000u); }
__device__ __forceinline__ float wave_sum(float v) {
#pragma unroll
    for (int o = 1; o < 64; o <<= 1) v += __shfl_xor(v, o);
    return v;
}
__device__ __forceinline__ float silu_f(float z) { return z / (1.f + __expf(-z)); }

__constant__ __attribute__((aligned(16))) float INVF[32] = {1.0f, 0.7498942613601685f, 0.5623413324356079f, 0.4216965138912201f, 0.3162277638912201f, 0.23713737726211548f, 0.17782793939113617f, 0.133352130651474f,
    0.10000000149011612f, 0.07498941570520401f, 0.05623413249850273f, 0.04216965287923813f, 0.03162277489900589f, 0.023713737726211548f, 0.017782794311642647f, 0.01333521492779255f,
    0.009999999776482582f, 0.007498941849917173f, 0.005623413249850273f, 0.0042169648222625256f, 0.003162277629598975f, 0.00237137358635664f, 0.0017782794311642647f, 0.0013335214462131262f,
    0.0010000000474974513f, 0.0007498942431993783f, 0.000562341301701963f, 0.0004216965171508491f, 0.0003162277571391314f, 0.00023713737027719617f, 0.00017782794020604342f, 0.0001333521504420787f};

struct Args {
    const float* x; const float* c; const int* pos; const float* ada_w; const float* ada_b; const float* norm_g; const float* w_in; const float* conv_w;
    const float* q_a_g; const float* w_q_b; const float* kv_a_g; const float* w_kv_b; const float* q_g; const float* k_g; const float* w_out;
    float* out; unsigned char* ws; int ph_lo, ph_hi;
};

__device__ __forceinline__ int in_row_map(int j) {
    if (j < 4096) { const int ko = j >> 10, ch = j & 1023, k = (ko == 1) ? 2 : (ko == 2) ? 1 : ko;
        return (ch >> 6) * 256 + (k >> 1) * 128 + ((ch >> 4) & 3) * 32 + (k & 1) * 16 + (ch & 15); }
    const int jj = j & 31; return (j & ~31) + 16 * ((jj >> 2) & 1) + 4 * (jj >> 3) + (jj & 3);
}
template <bool MAP>
__device__ __forceinline__ void p0_transpose_item(const float* __restrict__ W, int K, int N, bf16r* __restrict__ WT, LAS float* scr, int item, int lane) {
    const int nblk = N / 32, kb = item / nblk, nb = item % nblk, k0 = 64 * kb, n0 = 32 * nb;
    float wv[32];
#pragma unroll
    for (int i = 0; i < 32; ++i) wv[i] = __builtin_nontemporal_load(W + (size_t)(k0 + 2 * i + (lane >> 5)) * N + n0 + (lane & 31));
#pragma unroll
    for (int i = 0; i < 32; ++i) scr[(2 * i + (lane >> 5)) * 33 + (lane & 31)] = wv[i];
    asm volatile("s_waitcnt lgkmcnt(0)" ::: "memory");
    const int c = lane & 7;
#pragma unroll
    for (int j = 0; j < 4; ++j) { const int n = (lane >> 3) + 8 * j; const LAS float* s = scr + (8 * c) * 33 + n;
        v4u o; o.x = pk2(s[0 * 33], s[1 * 33]); o.y = pk2(s[2 * 33], s[3 * 33]); o.z = pk2(s[4 * 33], s[5 * 33]); o.w = pk2(s[6 * 33], s[7 * 33]);
        const int nr = MAP ? in_row_map(n0 + n) : n0 + n;
        *(v4u*)(WT + (size_t)nr * K + k0 + 8 * c) = o; }
    asm volatile("s_waitcnt lgkmcnt(0)" ::: "memory");
}

__device__ __forceinline__ void phase0(const Args& a, LAS unsigned char* lds) {
    const int tid = threadIdx.x, wid = __builtin_amdgcn_readfirstlane(tid >> 6), lane = tid & 63;
    const int G = gridDim.x, bid = blockIdx.x;
    unsigned char* ws = a.ws;
    LAS float* sc = (LAS float*)lds;
    LAS float* red = (LAS float*)(lds + 16384);
    LAS float* scr = (LAS float*)(lds + 32768 + wid * 8448);
    float* MOD = (float*)(ws + WS_MOD);
    constexpr int N_GEMV = (3 * DM) / 32;
    if (bid < N_GEMV) {
        for (int i = tid; i < 2 * DM; i += NTHREADS) sc[i] = silu_f(a.c[i]);
        __syncthreads();
        for (int it = bid; it < N_GEMV; it += G) {
            const int n0 = it * 32, cl = lane & 7, ks = lane >> 3;
            const float* wp = a.ada_w + (size_t)(wid * 256 + ks) * (3 * DM) + n0 + cl * 4;
            f32x4 acc0 = {0.f, 0.f, 0.f, 0.f}, acc1 = {0.f, 0.f, 0.f, 0.f};
#pragma unroll 16
            for (int j = 0; j < 32; ++j) { const f32x4 w = __builtin_nontemporal_load((const f32x4*)(wp + (size_t)j * 8 * (3 * DM))); const int k = wid * 256 + j * 8 + ks;
                acc0 += w * sc[k]; acc1 += w * sc[DM + k]; }
#pragma unroll
            for (int e = 0; e < 4; ++e) {
#pragma unroll
                for (int o = 8; o < 64; o <<= 1) { acc0[e] += __shfl_xor(acc0[e], o); acc1[e] += __shfl_xor(acc1[e], o); } }
            if (ks == 0) {
#pragma unroll
                for (int e = 0; e < 4; ++e) { red[(wid * 2 + 0) * 32 + cl * 4 + e] = acc0[e]; red[(wid * 2 + 1) * 32 + cl * 4 + e] = acc1[e]; } }
            __syncthreads();
            if (tid < 64) { const int b = tid >> 5, col = tid & 31; float s = a.ada_b[n0 + col];
#pragma unroll
                for (int w = 0; w < 8; ++w) s += red[(w * 2 + b) * 32 + col];
                MOD[b * (3 * DM) + n0 + col] = s; }
            __syncthreads();
        }
    }
    constexpr int I_IN = (DM / 64) * (IN_COLS / 32), I_Q = (Q_LORA / 64) * (NQ / 32), I_KV = (KV_LORA / 64) * (NKV / 32), I_OUT = (DM / 64) * (DM / 32);
    constexpr int NITEMS = I_IN + I_Q + I_KV + I_OUT, NGROUPS = (NITEMS + 7) / 8;
    bf16r* WinT = (bf16r*)(ws + WS_WIN); bf16r* WqT = (bf16r*)(ws + WS_WQ); bf16r* WkvT = (bf16r*)(ws + WS_WKV); bf16r* WoutT = (bf16r*)(ws + WS_WOUT);
    const int nfree = G > N_GEMV ? G - N_GEMV : 0;
    const int head = nfree * 4 < NGROUPS ? nfree * 4 : 0;
    for (int pass = 0; pass < 2; ++pass) {
        int g, gstep, gend;
        if (pass == 0) { if (bid < N_GEMV || head == 0) continue; g = bid - N_GEMV; gstep = nfree; gend = head; }
        else { g = head + bid; gstep = G; gend = NGROUPS; }
        for (; g < gend; g += gstep) {
            int r = g * 8 + wid; if (r >= NITEMS) continue;
            if (r < I_IN) { p0_transpose_item<true>(a.w_in, DM, IN_COLS, WinT, scr, r, lane); continue; } r -= I_IN;
            if (r < I_Q) { p0_transpose_item<false>(a.w_q_b, Q_LORA, NQ, WqT, scr, r, lane); continue; } r -= I_Q;
            if (r < I_KV) { p0_transpose_item<false>(a.w_kv_b, KV_LORA, NKV, WkvT, scr, r, lane); continue; } r -= I_KV;
            p0_transpose_item<false>(a.w_out, DM, DM, WoutT, scr, r, lane);
        }
    }
    { v4u* z = (v4u*)(WinT + (size_t)IN_COLS * DM); const int nz = (IN_PAD - IN_COLS) * DM / 8;
      for (int i = bid * NTHREADS + tid; i < nz; i += G * NTHREADS) z[i] = (v4u){0u, 0u, 0u, 0u}; }
}

__device__ __forceinline__ void phase1(const Args& a) {
    const int tid = threadIdx.x, wid = __builtin_amdgcn_readfirstlane(tid >> 6), lane = tid & 63;
    const int gw = blockIdx.x * NWAVES + wid, NGW = gridDim.x * NWAVES;
    const float* MOD = (const float*)(a.ws + WS_MOD); bf16r* H = (bf16r*)(a.ws + WS_H);
    f32x4 A[8], Bc[8], nx[8]; int curb = -1;
    { const int m0 = gw < M ? gw : 0; const f32x4* xn = (const f32x4*)(a.x + (size_t)m0 * DM) + 2 * lane;
#pragma unroll
      for (int j = 0; j < 8; ++j) nx[j] = __builtin_nontemporal_load(xn + 128 * (j >> 1) + (j & 1)); }
    for (int m = gw; m < M; m += NGW) {
        const int b = m / SEQ;
        if (b != curb) { curb = b;
#pragma unroll
            for (int j = 0; j < 8; ++j) { const int col = 8 * lane + 512 * (j >> 1) + 4 * (j & 1); const f32x4 g = *(const f32x4*)(a.norm_g + col);
                const f32x4 s = *(const f32x4*)(MOD + b * (3 * DM) + DM + col); A[j] = g * (s + 1.0f); Bc[j] = *(const f32x4*)(MOD + b * (3 * DM) + col); } }
        f32x4 v[8]; float ss = 0.f;
#pragma unroll
        for (int j = 0; j < 8; ++j) { v[j] = nx[j]; ss += (v[j].x * v[j].x + v[j].y * v[j].y) + (v[j].z * v[j].z + v[j].w * v[j].w); }
        { const int mn = (m + NGW < M) ? m + NGW : m; const f32x4* xn = (const f32x4*)(a.x + (size_t)mn * DM) + 2 * lane;
#pragma unroll
          for (int j = 0; j < 8; ++j) nx[j] = __builtin_nontemporal_load(xn + 128 * (j >> 1) + (j & 1)); }
        const float rstd = 1.0f / sqrtf(wave_sum(ss) * (1.f / DM) + EPS);
        v4u* o16 = (v4u*)(H + (size_t)m * DM) + lane;
#pragma unroll
        for (int j = 0; j < 4; ++j) { const f32x4 h0 = (v[2 * j] * rstd) * A[2 * j] + Bc[2 * j], h1 = (v[2 * j + 1] * rstd) * A[2 * j + 1] + Bc[2 * j + 1];
            v4u o; o.x = pk2(h0.x, h0.y); o.y = pk2(h0.z, h0.w); o.z = pk2(h1.x, h1.y); o.w = pk2(h1.z, h1.w);
            o16[64 * j] = o; }
    }
}

__device__ __forceinline__ void unpack8(const v4u w, float* f) { f[0] = bfl(w.x); f[1] = bfh(w.x); f[2] = bfl(w.y); f[3] = bfh(w.y); f[4] = bfl(w.z); f[5] = bfh(w.z); f[6] = bfl(w.w); f[7] = bfh(w.w); }
struct P3Row { v4u u2[2], gz[2], cq, ckv; };
__device__ __forceinline__ P3Row p3_load(const bf16r* U, int m, int lane) {
    const bf16r* ur = U + (size_t)m * IN_PAD; P3Row r;
#pragma unroll
    for (int q = 0; q < 2; ++q) { const int c16 = (lane + 64 * q) * 16;
        const v4u A = __builtin_nontemporal_load((const v4u*)(ur + c16)), B = __builtin_nontemporal_load((const v4u*)(ur + c16 + 8)); r.u2[q] = (v4u){A.x, A.y, B.x, B.y}; r.gz[q] = (v4u){A.z, A.w, B.z, B.w}; }
    r.cq = __builtin_nontemporal_load((const v4u*)(ur + OFF_CQ + lane * 8)); r.ckv = __builtin_nontemporal_load((const v4u*)(ur + OFF_CKV + (lane & 31) * 8));
    return r;
}
__device__ __forceinline__ void phase3(const Args& a) {
    const int tid = threadIdx.x, wid = __builtin_amdgcn_readfirstlane(tid >> 6), lane = tid & 63;
    const int gw = blockIdx.x * NWAVES + wid, NGW = gridDim.x * NWAVES;
    const bf16r* U = (const bf16r*)(a.ws + WS_U); bf16r* Y = (bf16r*)(a.ws + WS_H);
    bf16r* CQN = (bf16r*)(a.ws + WS_CQN); bf16r* CKVN = (bf16r*)(a.ws + WS_CKVN);
    const int rpw = (M + NGW - 1) / NGW, m0 = gw * rpw, m1 = (m0 + rpw < M) ? m0 + rpw : M;
    if (m0 >= M) return;
    float w0[2][8], w1[2][8], w2[2][8];
#pragma unroll
    for (int q = 0; q < 2; ++q) { const int ch = (lane + 64 * q) * 8;
#pragma unroll
        for (int e = 0; e < 8; ++e) { w0[q][e] = a.conv_w[ch + e]; w1[q][e] = a.conv_w[D_CONV + ch + e]; w2[q][e] = a.conv_w[2 * D_CONV + ch + e]; } }
    const f32x4 gqa = *(const f32x4*)(a.q_a_g + lane * 8), gqb = *(const f32x4*)(a.q_a_g + lane * 8 + 4);
    const f32x4 gka = *(const f32x4*)(a.kv_a_g + (lane & 31) * 8), gkb = *(const f32x4*)(a.kv_a_g + (lane & 31) * 8 + 4);
    const v4u zero4 = {0u, 0u, 0u, 0u};
    v4u pm1[2], pm2[2];
    { const int t0 = m0 % SEQ;
#pragma unroll
      for (int q = 0; q < 2; ++q) { const int ch = (lane + 64 * q) * 8;
          if (t0 >= 1) { const bf16r* p = U + (size_t)(m0 - 1) * IN_PAD + 2 * ch; const v4u A = *(const v4u*)p, B = *(const v4u*)(p + 8); pm1[q] = (v4u){A.x, A.y, B.x, B.y}; } else pm1[q] = zero4;
          if (t0 >= 2) { const bf16r* p = U + (size_t)(m0 - 2) * IN_PAD + 2 * ch; const v4u A = *(const v4u*)p, B = *(const v4u*)(p + 8); pm2[q] = (v4u){A.x, A.y, B.x, B.y}; } else pm2[q] = zero4; } }
    P3Row cur = p3_load(U, m0, lane);
    for (int m = m0; m < m1; ++m) {
        const P3Row nxt = p3_load(U, (m + 1 < m1) ? m + 1 : m, lane);
        if (m % SEQ == 0) { pm1[0] = zero4; pm1[1] = zero4; pm2[0] = zero4; pm2[1] = zero4; }
#pragma unroll
        for (int q = 0; q < 2; ++q) {
            const int ch = (lane + 64 * q) * 8;
            float c0[8], c1[8], c2[8], g[8], y[8];
            unpack8(cur.u2[q], c0); unpack8(pm1[q], c1); unpack8(pm2[q], c2); unpack8(cur.gz[q], g);
#pragma unroll
            for (int e = 0; e < 8; ++e) y[e] = g[e] * (w2[q][e] * c0[e] + w1[q][e] * c1[e] + w0[q][e] * c2[e]);
            v4u o; o.x = pk2(y[0], y[1]); o.y = pk2(y[2], y[3]); o.z = pk2(y[4], y[5]); o.w = pk2(y[6], y[7]);
            *(v4u*)(Y + (size_t)m * DM + ch) = o;
            pm2[q] = pm1[q]; pm1[q] = cur.u2[q];
        }
        { float f[8]; unpack8(cur.cq, f); float ss = 0.f;
#pragma unroll
          for (int e = 0; e < 8; ++e) ss += f[e] * f[e];
          const float rstd = 1.0f / sqrtf(wave_sum(ss) * (1.f / Q_LORA) + EPS);
          v4u o; o.x = pk2(f[0] * rstd * gqa.x, f[1] * rstd * gqa.y); o.y = pk2(f[2] * rstd * gqa.z, f[3] * rstd * gqa.w);
          o.z = pk2(f[4] * rstd * gqb.x, f[5] * rstd * gqb.y); o.w = pk2(f[6] * rstd * gqb.z, f[7] * rstd * gqb.w);
          *(v4u*)(CQN + (size_t)m * Q_LORA + lane * 8) = o; }
        { float f[8]; const int l2 = lane & 31; unpack8(cur.ckv, f); float ss = 0.f;
#pragma unroll
          for (int e = 0; e < 8; ++e) ss += f[e] * f[e];
          if (lane >= 32) ss = 0.f;
          const float rstd = 1.0f / sqrtf(wave_sum(ss) * (1.f / KV_LORA) + EPS);
          v4u o; o.x = pk2(f[0] * rstd * gka.x, f[1] * rstd * gka.y); o.y = pk2(f[2] * rstd * gka.z, f[3] * rstd * gka.w);
          o.z = pk2(f[4] * rstd * gkb.x, f[5] * rstd * gkb.y); o.w = pk2(f[6] * rstd * gkb.z, f[7] * rstd * gkb.w);
          if (lane < 32) *(v4u*)(CKVN + (size_t)m * KV_LORA + l2 * 8) = o; }
        cur = nxt;
    }
}

struct P5Row { v4u k0, k1, kr; int pos; };
__device__ __forceinline__ P5Row p5_load(const Args& a, int m, int hh, int sub) {
    const bf16r* U = (const bf16r*)(a.ws + WS_U); const bf16r* Q = (const bf16r*)(a.ws + WS_QRAW); const bf16r* KVR = (const bf16r*)(a.ws + WS_KVRAW);
    P5Row r;
    const bf16r* kn = KVR + (size_t)m * NKV + hh * 256 + sub * 16;
    r.k0 = *(const v4u*)(kn); r.k1 = *(const v4u*)(kn + 8);
    r.kr = *(const v4u*)(U + (size_t)m * IN_PAD + OFF_KR + sub * 8);
    r.pos = a.pos[m];
    return r;
}
__device__ __forceinline__ float grp8_sum(float v) { v += __shfl_xor(v, 1); v += __shfl_xor(v, 2); v += __shfl_xor(v, 4); return v; }
__device__ __forceinline__ void p5_proc(const Args& a, int m, int hh, int sub, const P5Row& r, const float* qg, const float* kg, const float* invf) {
    bf16r* Q = (bf16r*)(a.ws + WS_QRAW); bf16r* KF = (bf16r*)(a.ws + WS_KF);
    const int b = m / SEQ, s = m % SEQ;
    float cs[8], sg[8];
#pragma unroll
    for (int e = 0; e < 8; ++e) { const float ang = (float)r.pos * invf[e];
        double rev = (double)ang * 0.15915494309189535; rev -= __builtin_rint(rev); const float fr = (float)rev;
        cs[e] = __builtin_amdgcn_cosf(fr); const float sn = __builtin_amdgcn_sinf(fr); sg[e] = sub < 4 ? -sn : sn; }
    { float n0[8], n1[8], kr[8]; unpack8(r.k0, n0); unpack8(r.k1, n1); unpack8(r.kr, kr);
      float ss = 0.f;
#pragma unroll
      for (int e = 0; e < 8; ++e) ss += n0[e] * n0[e] + n1[e] * n1[e] + kr[e] * kr[e];
      const float rstd = 1.0f / sqrtf(grp8_sum(ss) * (1.f / QK_HEAD) + EPS);
      float y[8];
#pragma unroll
      for (int e = 0; e < 8; ++e) { n0[e] = n0[e] * rstd * kg[e]; n1[e] = n1[e] * rstd * kg[8 + e]; y[e] = kr[e] * rstd * kg[16 + e]; }
#pragma unroll
      for (int e = 0; e < 8; ++e) { const float pr = __shfl_xor(y[e], 4); kr[e] = y[e] * cs[e] + pr * sg[e]; }
      bf16r* ko = KF + ((size_t)(b * NHEAD + hh) * SEQ + s) * QK_HEAD;
      v4u o; o.x = pk2(n0[0], n0[1]); o.y = pk2(n0[2], n0[3]); o.z = pk2(n0[4], n0[5]); o.w = pk2(n0[6], n0[7]); *(v4u*)(ko + sub * 16) = o;
      o.x = pk2(n1[0], n1[1]); o.y = pk2(n1[2], n1[3]); o.z = pk2(n1[4], n1[5]); o.w = pk2(n1[6], n1[7]); *(v4u*)(ko + sub * 16 + 8) = o;
      o.x = pk2(kr[0], kr[1]); o.y = pk2(kr[2], kr[3]); o.z = pk2(kr[4], kr[5]); o.w = pk2(kr[6], kr[7]); *(v4u*)(ko + 128 + sub * 8) = o; }
}
__device__ __forceinline__ void phase5(const Args& a) {
    const int tid = threadIdx.x, wid = __builtin_amdgcn_readfirstlane(tid >> 6), lane = tid & 63, hh = lane >> 3, sub = lane & 7;
    const int gw = blockIdx.x * NWAVES + wid, NGW = gridDim.x * NWAVES;
    float qg[24], kg[24], invf[8];
    constexpr float QS = 0.07216878364870322f * 1.4426950408889634f;
#pragma unroll
    for (int e = 0; e < 8; ++e) { qg[e] = a.q_g[sub * 8 + e] * QS; qg[8 + e] = a.q_g[64 + sub * 8 + e] * QS; qg[16 + e] = a.q_g[128 + sub * 8 + e] * QS;
        kg[e] = a.k_g[sub * 16 + e]; kg[8 + e] = a.k_g[sub * 16 + 8 + e]; kg[16 + e] = a.k_g[128 + sub * 8 + e]; invf[e] = INVF[(sub & 3) * 8 + e]; }
    for (int m = gw; m < M; m += 2 * NGW) {
        const int m2 = m + NGW; const bool has2 = m2 < M;
        const P5Row r0 = p5_load(a, m, hh, sub); const P5Row r1 = p5_load(a, has2 ? m2 : m, hh, sub);
        p5_proc(a, m, hh, sub, r0, qg, kg, invf);
        if (has2) p5_proc(a, m2, hh, sub, r1, qg, kg, invf);
    }
}

#define XB_TMO      128
#define XB_XCNT(j)  (256  + 64 * (j))
#define XB_XSUB(j)  (1280 + 64 * (j))
#define XB_XGEN(j)  (2304 + 64 * (j))
#define XB_TOP      3328
#define XB_TOPGEN   3392
#define XCD_BAR_WORDS 3456
#define XB_SPIN_CAP (1u << 18)

__device__ __forceinline__ unsigned xb_ld(unsigned* p)              { return __hip_atomic_load(p, __ATOMIC_RELAXED, __HIP_MEMORY_SCOPE_AGENT); }
__device__ __forceinline__ unsigned xb_add(unsigned* p, unsigned v) { return __hip_atomic_fetch_add(p, v, __ATOMIC_RELAXED, __HIP_MEMORY_SCOPE_AGENT); }
__device__ __forceinline__ unsigned xb_xcc_id() { return (unsigned)__builtin_amdgcn_s_getreg((3 << 11) | 20) & 0xFu; }
#define XB_SPIN(cond, bar) do { unsigned _sp = 0; while (cond) { __builtin_amdgcn_s_sleep(1); \
    if ((++_sp & 255u) == 0u) { if (xb_ld(&(bar)[XB_TMO])) break; if (_sp > XB_SPIN_CAP) { atomicAdd(&(bar)[XB_TMO], 1u); break; } } } } while (0)

struct XcdBarrier {
    unsigned* bar; unsigned x;
    volatile LAS unsigned* st;
};

__device__ __forceinline__ XcdBarrier xcd_barrier_post(unsigned* bar, volatile LAS unsigned* st) {
    XcdBarrier b; b.bar = bar; b.x = xb_xcc_id(); b.st = st;
    if (threadIdx.x == 0) (void)xb_add(&bar[XB_XCNT(b.x)], 1u);
    return b;
}
__device__ __forceinline__ void xcd_barrier_complete(unsigned* bar, unsigned x, unsigned& nloc, unsigned& nx) {
    const unsigned G = gridDim.x * gridDim.y * gridDim.z;
    unsigned sum, cnt, mine, sp = 0u;
    for (;;) {
        sum = 0u; cnt = 0u; mine = 0u;
#pragma unroll
        for (unsigned j = 0; j < 16; ++j) { const unsigned c = xb_ld(&bar[XB_XCNT(j)]); sum += c; cnt += (c > 0u) ? 1u : 0u; mine = (j == x) ? c : mine; }
        if (sum == G) break;
        __builtin_amdgcn_s_sleep(1);
        if ((++sp & 255u) == 0u) { if (xb_ld(&bar[XB_TMO])) break; if (sp > XB_SPIN_CAP) { atomicAdd(&bar[XB_TMO], 1u); break; } }
    }
    nloc = mine > 0u ? mine : 1u; nx = cnt > 0u ? cnt : 1u;
}

__device__ __forceinline__ void xcd_barrier(const XcdBarrier& b) {
    asm volatile("s_waitcnt vmcnt(0)" ::: "memory");
    __syncthreads();
    if (threadIdx.x == 0) {
        unsigned* bar = b.bar;
        __builtin_amdgcn_s_waitcnt(0);
        unsigned nloc = b.st[0], nx = b.st[1];
        if (nloc == 0u) { xcd_barrier_complete(bar, b.x, nloc, nx); b.st[0] = nloc; b.st[1] = nx; }
        const unsigned old = xb_add(&bar[XB_XSUB(b.x)], 1u);
        const unsigned gen = old / nloc;
        if (old + 1u == (gen + 1u) * nloc) {
            __builtin_amdgcn_fence(__ATOMIC_RELEASE, "agent");
            asm volatile("s_waitcnt vmcnt(0)" ::: "memory");
            const unsigned og = xb_add(&bar[XB_TOP], 1u);
            const unsigned tg = og / nx;
            if (og + 1u == (tg + 1u) * nx) xb_add(&bar[XB_TOPGEN], 1u);
            else XB_SPIN(xb_ld(&bar[XB_TOPGEN]) == tg, bar);
            __builtin_amdgcn_fence(__ATOMIC_ACQUIRE, "agent");
            xb_add(&bar[XB_XGEN(b.x)], 1u);
            asm volatile("s_waitcnt vmcnt(0)" ::: "memory");
        } else {
            XB_SPIN(xb_ld(&bar[XB_XGEN(b.x)]) == gen, bar);
            __builtin_amdgcn_fence(__ATOMIC_ACQUIRE, "agent");
            asm volatile("s_waitcnt vmcnt(0)" ::: "memory");
        }
    }
    __syncthreads();
}
__global__ void __launch_bounds__(NTHREADS, 2) hymba_fwd(Args a) {
    extern __shared__ __attribute__((aligned(16))) unsigned char lds[];
    cg::grid_group grid = cg::this_grid();
    if (a.ph_hi > 1000) grid.sync();
    LAS unsigned char* l3 = (LAS unsigned char*)lds;
    unsigned char* ws = a.ws;
    const int G = gridDim.x, bid = blockIdx.x;
    const int lo = a.ph_lo, hi = a.ph_hi;
#define IN(k) (lo <= (k) && (k) < hi)
    volatile LAS unsigned* st = (volatile LAS unsigned*)(l3 + LDS_BYTES - 256);
    if (threadIdx.x < 2) st[threadIdx.x] = 0u;
    __syncthreads();
    XcdBarrier bar; bar.bar = (unsigned*)ws; bar.x = 0; bar.st = nullptr;
    if (hi - lo > 1) bar = xcd_barrier_post((unsigned*)ws, st);
#define SEAM(k) do { if (IN(k) && IN((k) + 1)) xcd_barrier(bar); } while (0)
    bf16r* WinT = (bf16r*)(ws + WS_WIN); bf16r* WqT = (bf16r*)(ws + WS_WQ); bf16r* WkvT = (bf16r*)(ws + WS_WKV); bf16r* WoutT = (bf16r*)(ws + WS_WOUT);
    bf16r* H = (bf16r*)(ws + WS_H); bf16r* U = (bf16r*)(ws + WS_U); bf16r* CQN = (bf16r*)(ws + WS_CQN); bf16r* CKVN = (bf16r*)(ws + WS_CKVN);
    bf16r* QRAW = (bf16r*)(ws + WS_QRAW); bf16r* KVRAW = (bf16r*)(ws + WS_KVRAW); bf16r* KF = (bf16r*)(ws + WS_KF);
    const float* MOD = (const float*)(ws + WS_MOD);

    if (IN(0)) phase0(a, l3);
    SEAM(0);
    if (IN(1)) phase1(a);
    SEAM(1);
    if (IN(2)) {
        pg8::Gemm g{H, WinT, M, IN_PAD, DM}; pg8::StaticOrder S; S.init(M, IN_PAD, G, bid);
        pg8::EpiIn E{U, IN_PAD};
        pg8::gemm_phase<pg8::EpiIn, pg8::StaticOrder, true, true>(l3, g, S, E);
    }
    SEAM(2);
    if (IN(3)) phase3(a);
    SEAM(3);
    if (IN(4)) {
        { pg8::Gemm g{CQN, WqT, M, NQ, Q_LORA}; pg8::StaticOrder S; S.init(M, NQ, G, bid);
          pg8::EpiBf16<0> E{QRAW, NQ, nullptr, 0, 0, 1.f};
          pg8::gemm_phase<pg8::EpiBf16<0>, pg8::StaticOrder, true, true>(l3, g, S, E); }
        __syncthreads();
        { pg8::Gemm g{CKVN, WkvT, M, NKV, KV_LORA}; pg8::KvOrder S; S.init(M, NKV, G, bid);
          pg8::EpiBf16<0> E{KVRAW, NKV, nullptr, 0, 0, 1.f};
          pg8::gemm_phase<pg8::EpiBf16<0>, pg8::KvOrder, true, true>(l3, g, S, E); }
    }
    SEAM(4);
    if (IN(5)) phase5(a);
    SEAM(5);
    if (IN(6)) {
        __syncthreads();
        const int vcu = (G % 8 == 0) ? (bid % 8) * (G / 8) + bid / 8 : bid;
        float bq, bk;
        { const int l = threadIdx.x & 63; bq = fmaxf(fmaxf(fabsf(a.q_g[l]), fabsf(a.q_g[64 + l])), fabsf(a.q_g[128 + l])); bk = fmaxf(fmaxf(fabsf(a.k_g[l]), fabsf(a.k_g[64 + l])), fabsf(a.k_g[128 + l]));
#pragma unroll
          for (int o = 1; o < 64; o <<= 1) { bq = fmaxf(bq, __shfl_xor(bq, o)); bk = fmaxf(bk, __shfl_xor(bk, o)); } }
        const bool fast = __builtin_amdgcn_readfirstlane((int)(19.99f * bq * bk <= 100.f)) != 0;
        if ((threadIdx.x >> 6) < 4) __builtin_amdgcn_s_setprio(1);
        for (int item = vcu; item < BATCH * NHEAD * 16; item += G) {
            const int bh = item >> 4, x = item & 15;
            if (fast) {
                att::attn_unit<true>(bh / NHEAD, bh % NHEAD, x, (const att::bf16*)QRAW, (const att::bf16*)KF, (const att::bf16*)KVRAW, (const att::bf16*)U, (att::bf16*)H, a.q_g, a.pos, INVF, (char*)lds);
                att::attn_unit<true>(bh / NHEAD, bh % NHEAD, 31 - x, (const att::bf16*)QRAW, (const att::bf16*)KF, (const att::bf16*)KVRAW, (const att::bf16*)U, (att::bf16*)H, a.q_g, a.pos, INVF, (char*)lds);
            } else {
                att::attn_unit<false>(bh / NHEAD, bh % NHEAD, x, (const att::bf16*)QRAW, (const att::bf16*)KF, (const att::bf16*)KVRAW, (const att::bf16*)U, (att::bf16*)H, a.q_g, a.pos, INVF, (char*)lds);
                att::attn_unit<false>(bh / NHEAD, bh % NHEAD, 31 - x, (const att::bf16*)QRAW, (const att::bf16*)KF, (const att::bf16*)KVRAW, (const att::bf16*)U, (att::bf16*)H, a.q_g, a.pos, INVF, (char*)lds);
            }
        }
    }
    if (IN(6)) __builtin_amdgcn_s_setprio(0);
    SEAM(6);
    if (IN(7)) {
        __syncthreads();
        pg8::Gemm g{H, WoutT, M, DM, DM}; pg8::StaticOrder S; S.init(M, DM, G, bid);
        pg8::EpiOut E{a.x, MOD + 2 * DM, a.out, DM, SEQ, 3 * DM};
        pg8::gemm_phase<pg8::EpiOut, pg8::StaticOrder, true, true>(l3, g, S, E);
    }
#undef IN
#undef SEAM
}

#ifndef N_LAUNCH_MODE
#define N_LAUNCH_MODE 1
#endif
extern "C" void kernel_launch(void* const* d_in, const int* in_sizes, int n_in, void* d_out, int out_size, void* d_ws, size_t ws_size, hipStream_t stream) {
    static int grid = 0;
    if (grid == 0) {
        if (n_in != 15 || in_sizes[0] != M * DM || out_size != M * DM || ws_size < WS_END) { fprintf(stderr, "kernel_launch: unexpected shapes (n_in %d, in0 %d, out %d, ws %zu)\n", n_in, n_in > 0 ? in_sizes[0] : -1, out_size, ws_size); grid = -1; return; }
        int dev = 0, cus = 0, per_cu = 0;
        (void)hipGetDevice(&dev); (void)hipDeviceGetAttribute(&cus, hipDeviceAttributeMultiprocessorCount, dev);
        if (hipFuncSetAttribute((const void*)hymba_fwd, hipFuncAttributeMaxDynamicSharedMemorySize, LDS_BYTES) != hipSuccess) { fprintf(stderr, "kernel_launch: hipFuncSetAttribute failed\n"); grid = -1; return; }
        if (hipOccupancyMaxActiveBlocksPerMultiprocessor(&per_cu, (const void*)hymba_fwd, NTHREADS, LDS_BYTES) != hipSuccess || per_cu < 1) per_cu = 1;
        (void)hipGetLastError();
        if (cus <= 0) cus = 256;
        grid = cus;
    }
    if (grid < 0) return;
    if (hipMemsetAsync(d_ws, 0, 65536, stream) != hipSuccess) { fprintf(stderr, "kernel_launch: memset failed\n"); return; }
    Args a{};
    a.x = (const float*)d_in[0]; a.c = (const float*)d_in[1]; a.pos = (const int*)d_in[2]; a.ada_w = (const float*)d_in[3]; a.ada_b = (const float*)d_in[4];
    a.norm_g = (const float*)d_in[5]; a.w_in = (const float*)d_in[6]; a.conv_w = (const float*)d_in[7]; a.q_a_g = (const float*)d_in[8]; a.w_q_b = (const float*)d_in[9];
    a.kv_a_g = (const float*)d_in[10]; a.w_kv_b = (const float*)d_in[11]; a.q_g = (const float*)d_in[12]; a.k_g = (const float*)d_in[13]; a.w_out = (const float*)d_in[14];
    a.out = (float*)d_out; a.ws = (unsigned char*)d_ws;
#if N_LAUNCH_MODE == 1
    a.ph_lo = 0; a.ph_hi = 8;
    void* args[] = {&a};
    hipError_t e = hipLaunchCooperativeKernel((const void*)hymba_fwd, dim3(grid), dim3(NTHREADS), args, LDS_BYTES, stream);
    if (e != hipSuccess) fprintf(stderr, "kernel_launch: cooperative launch failed: %s (grid %d)\n", hipGetErrorString(e), grid);
#else
    for (int p = 0; p < 8; ++p) { a.ph_lo = p; a.ph_hi = p + 1; hipLaunchKernelGGL(hymba_fwd, dim3(grid), dim3(NTHREADS), LDS_BYTES, stream, a); }
#endif
}
```
